# Optimizing an MI355X kernel written in HIP

```python
import jax
import jax.numpy as jnp
from jax import lax
import numpy as np

D_MODEL = 1024
BATCH = 1
SEQ = 16384
DEPTH = 4

HEAD_DIM = 64
RWKV_HEADS = (3 * D_MODEL) // (8 * HEAD_DIM)
DSA_HEADS = D_MODEL // (4 * HEAD_DIM)
SWA_HEADS = D_MODEL // HEAD_DIM - RWKV_HEADS - DSA_HEADS
SWA_KV_HEADS = 2
RWKV_W = RWKV_HEADS * HEAD_DIM
DSA_W = DSA_HEADS * HEAD_DIM
SWA_W = SWA_HEADS * HEAD_DIM
DECAY_LORA = 64
AAA_LORA = 64
GATE_LORA = 128
GN_EPS = 64e-5
KV_LORA = 128
IDX_HEADS = 4
IDX_DIM = 64
TOPK_MAX = 256
Q_BLOCK = 128
WINDOW = 128
N_EXPERTS = 64
TOP_K = 8
N_GROUPS = 8
TOPK_GROUPS = 4
D_EXPERT = 256
ROUTED_SCALE = 2.5
MOE_BLOCK = 128
ALPHA = (2 * DEPTH) ** 0.25
BETA = (8 * DEPTH) ** -0.25
LN_EPS = 1e-5
NEG = -1e30

RWKV_SIZES = (RWKV_W, RWKV_W, RWKV_W, DECAY_LORA, AAA_LORA, GATE_LORA)
DSA_SIZES = (DSA_W, KV_LORA, IDX_HEADS * IDX_DIM, IDX_DIM, IDX_HEADS)
SWA_SIZES = (SWA_W, SWA_KV_HEADS * HEAD_DIM, SWA_KV_HEADS * HEAD_DIM)
N_RWKV_COLS = sum(RWKV_SIZES)
N_DSA_COLS = sum(DSA_SIZES)
N_SWA_COLS = sum(SWA_SIZES)
P_IN = N_RWKV_COLS + N_DSA_COLS + N_SWA_COLS

kernel_name = 'hybrid_rwkv7_dsa_swa_moe_deepnorm'


def split_cols(t, sizes):
    return jnp.split(t, [int(s) for s in np.cumsum(sizes)[:-1]], axis=-1)


def layer_norm(x, g, b):
    xf = x.astype(jnp.float32)
    mu = xf.mean(-1, keepdims=True)
    var = jnp.square(xf - mu).mean(-1, keepdims=True)
    return ((xf - mu) * lax.rsqrt(var + LN_EPS)).astype(x.dtype) * g + b


def rms_norm(x, g):
    xf = x.astype(jnp.float32)
    return (xf * lax.rsqrt(jnp.mean(xf * xf, -1, keepdims=True) + 1e-6)).astype(x.dtype) * g


def token_shift(y):
    return jnp.pad(y, ((0, 0), (1, 0), (0, 0)))[:, :-1]


def alibi_slopes(n):
    return 2.0 ** (-8.0 * (jnp.arange(n, dtype=jnp.float32) + 1.0) / n)


def swiglu(t, w1, w3, w2):
    return (jax.nn.silu(t @ w1) * (t @ w3)) @ w2


def rwkv7_mix(cols, mu, w0, w2, a0, a2, g2, k_k, k_a, r_k, ln_g, ln_b):
    B, L, _ = cols.shape
    f32 = jnp.float32
    cols = cols + (token_shift(cols) - cols) * mu
    r, k, v, wl, al, gl = split_cols(cols, RWKV_SIZES)
    w = -jax.nn.softplus(-(w0 + jnp.tanh(wl) @ w2)) - 0.5
    a = jax.nn.sigmoid(a0 + al @ a2)
    g = jax.nn.sigmoid(gl) @ g2
    heads = lambda t: t.reshape(B, L, RWKV_HEADS, HEAD_DIM)
    kk = heads(k * k_k).astype(f32)
    kk = kk / jnp.maximum(jnp.sqrt(jnp.sum(kk * kk, -1, keepdims=True)), 1e-12)
    k = k * (1 + (a - 1) * k_a)
    rh, kh, vh, ah = heads(r), heads(k), heads(v), heads(a)
    decay = jnp.exp(-jnp.exp(heads(w).astype(f32)))
    tmaj = lambda t: jnp.moveaxis(t.astype(f32), 1, 0)

    def step(S, inp):
        r_t, w_t, k_t, v_t, kk_t, a_t = inp
        sa = jnp.einsum('bhvk,bhk->bhv', S, -kk_t)
        S = (S * w_t[:, :, None, :] + sa[..., None] * (kk_t * a_t)[:, :, None, :]
             + v_t[..., None] * k_t[:, :, None, :])
        return S, jnp.einsum('bhvk,bhk->bhv', S, r_t)

    S0 = jnp.zeros((B, RWKV_HEADS, HEAD_DIM, HEAD_DIM), f32)
    _, o = lax.scan(step, S0, (tmaj(rh), tmaj(decay), tmaj(kh), tmaj(vh), tmaj(kk), tmaj(ah)))
    o = jnp.moveaxis(o, 0, 1)
    mean = o.mean(-1, keepdims=True)
    var = jnp.square(o - mean).mean(-1, keepdims=True)
    o = ((o - mean) * lax.rsqrt(var + GN_EPS)).reshape(B, L, RWKV_W).astype(cols.dtype) * ln_g + ln_b
    bonus = jnp.sum(rh * kh * r_k, -1, keepdims=True) * vh
    return (o + bonus.reshape(B, L, RWKV_W)) * g


def dsa_mix(cols, kv_norm, w_uk, w_uv, ik_g, ik_b, slopes):
    B, L, _ = cols.shape
    f32 = jnp.float32
    topk = min(TOPK_MAX, L // 4)
    q, c_kv, iq, ik, iw = split_cols(cols, DSA_SIZES)
    c_kv = rms_norm(c_kv, kv_norm)
    q = q.reshape(B, L, DSA_HEADS, HEAD_DIM)
    q_lat = jnp.einsum('blhd,hdr->blhr', q, w_uk) * HEAD_DIM ** -0.5
    iq = iq.reshape(B, L, IDX_HEADS, IDX_DIM).astype(f32)
    ik = layer_norm(ik, ik_g, ik_b).astype(f32)
    iw = iw.astype(f32) * (IDX_HEADS ** -0.5 * IDX_DIM ** -0.5)
    nb = L // Q_BLOCK
    blk = lambda t: jnp.moveaxis(t.reshape(B, nb, Q_BLOCK, *t.shape[2:]), 1, 0)
    key_pos = jnp.arange(L)
    gather = jax.vmap(lambda c, i: c[i])

    def one_block(args):
        q_b, iq_b, iw_b, pos_b = args
        s = jnp.einsum('bqhd,bkd->bqhk', iq_b, ik)
        score = jnp.einsum('bqhk,bqh->bqk', jax.nn.relu(s), iw_b)
        causal = key_pos[None, :] <= pos_b[:, None]
        score = jnp.where(causal[None], score, NEG)
        _, idx = lax.top_k(score, topk)
        c_sel = gather(c_kv, idx)
        valid = idx <= pos_b[None, :, None]
        dist = (pos_b[None, :, None] - idx).astype(f32)
        logits = jnp.einsum('bqhr,bqkr->bhqk', q_b, c_sel).astype(f32)
        logits = logits - slopes[:, None, None] * dist[:, None]
        logits = jnp.where(valid[:, None], logits, NEG)
        p = jax.nn.softmax(logits, axis=-1).astype(c_sel.dtype)
        return jnp.einsum('bhqk,bqkr->bqhr', p, c_sel)

    pos = jnp.arange(L).reshape(nb, Q_BLOCK)
    o_lat = lax.map(one_block, (blk(q_lat), blk(iq), blk(iw), pos))
    o_lat = jnp.moveaxis(o_lat, 0, 1).reshape(B, L, DSA_HEADS, KV_LORA)
    o = jnp.einsum('blhr,hrd->blhd', o_lat, w_uv)
    return o.reshape(B, L, DSA_W)


def swa_mix(cols, sinks, slopes):
    B, L, _ = cols.shape
    f32 = jnp.float32
    nb = L // WINDOW
    G = SWA_HEADS // SWA_KV_HEADS
    q, k, v = split_cols(cols, SWA_SIZES)
    q = q.reshape(B, nb, WINDOW, SWA_KV_HEADS, G, HEAD_DIM)
    k = k.reshape(B, nb, WINDOW, SWA_KV_HEADS, HEAD_DIM)
    v = v.reshape(B, nb, WINDOW, SWA_KV_HEADS, HEAD_DIM)
    prev = lambda t: jnp.pad(t, ((0, 0), (1, 0), (0, 0), (0, 0), (0, 0)))[:, :-1]
    k2 = jnp.concatenate([prev(k), k], axis=2)
    v2 = jnp.concatenate([prev(v), v], axis=2)
    s = jnp.einsum('bnqgrd,bnkgd->bngrqk', q, k2).astype(f32) * HEAD_DIM ** -0.5
    qi = jnp.arange(WINDOW)
    kj = jnp.arange(2 * WINDOW)
    dist = qi[:, None] + WINDOW - kj[None, :]
    key_abs = jnp.arange(nb)[:, None] * WINDOW - WINDOW + kj[None, :]
    valid = ((dist >= 0) & (dist < WINDOW))[None] & (key_abs >= 0)[:, None, :]
    s = s - slopes.reshape(SWA_KV_HEADS, G)[:, :, None, None] * dist.astype(f32)
    s = jnp.where(valid[None, :, None, None], s, NEG)
    sink = sinks.astype(f32).reshape(SWA_KV_HEADS, G)[None, None, :, :, None, None]
    m = jnp.maximum(s.max(-1, keepdims=True), sink)
    e = jnp.exp(s - m)
    p = e / (e.sum(-1, keepdims=True) + jnp.exp(sink - m))
    o = jnp.einsum('bngrqk,bnkgd->bnqgrd', p.astype(v2.dtype), v2)
    return o.reshape(B, L, SWA_W)


def grouped_experts(t, idx, gate, w1, w3, w2):
    T, D = t.shape
    A = T * TOP_K
    n_blocks = -(-A // MOE_BLOCK) + N_EXPERTS
    cap = n_blocks * MOE_BLOCK
    flat_e = idx.reshape(A)
    order = jnp.argsort(flat_e)
    e_sorted = flat_e[order]
    tok_sorted = (order // TOP_K).astype(jnp.int32)
    gate_sorted = gate.reshape(A)[order]
    counts = jnp.bincount(flat_e, length=N_EXPERTS)
    padded = (counts + MOE_BLOCK - 1) // MOE_BLOCK * MOE_BLOCK
    pad_end = jnp.cumsum(padded)
    pad_start = pad_end - padded
    start = jnp.cumsum(counts) - counts
    slot = pad_start[e_sorted] + jnp.arange(A) - start[e_sorted]
    slot_tok = jnp.full((cap,), T, jnp.int32).at[slot].set(tok_sorted)
    slot_gate = jnp.zeros((cap,), t.dtype).at[slot].set(gate_sorted)
    block_e = jnp.minimum(jnp.searchsorted(pad_end, jnp.arange(n_blocks) * MOE_BLOCK, side='right'), N_EXPERTS - 1)
    t_pad = jnp.concatenate([t, jnp.zeros((1, D), t.dtype)], axis=0)

    def one_block(args):
        tok_b, g_b, e = args
        xb = t_pad[tok_b]
        return swiglu(xb, w1[e], w3[e], w2[e]) * g_b[:, None]

    ys = lax.map(one_block, (slot_tok.reshape(n_blocks, MOE_BLOCK), slot_gate.reshape(n_blocks, MOE_BLOCK), block_e))
    return jnp.zeros((T + 1, D), t.dtype).at[slot_tok].add(ys.reshape(cap, D))[:T]


def moe_ffn(h, router_w, router_bias, w1, w3, w2, sw1, sw3, sw2):
    B, L, D = h.shape
    T = B * L
    t = h.reshape(T, D)
    scores = jax.nn.sigmoid((t @ router_w).astype(jnp.float32))
    sel = scores + router_bias
    grp_score = lax.top_k(sel.reshape(T, N_GROUPS, N_EXPERTS // N_GROUPS), 2)[0].sum(-1)
    _, top_g = lax.top_k(grp_score, TOPK_GROUPS)
    gmask = jax.nn.one_hot(top_g, N_GROUPS, dtype=jnp.float32).sum(1) > 0
    sel = jnp.where(jnp.repeat(gmask, N_EXPERTS // N_GROUPS, axis=1), sel, NEG)
    _, idx = lax.top_k(sel, TOP_K)
    gate = jnp.take_along_axis(scores, idx, axis=1)
    gate = (gate / gate.sum(-1, keepdims=True) * ROUTED_SCALE).astype(t.dtype)
    out = grouped_experts(t, idx, gate, w1, w3, w2) + swiglu(t, sw1, sw3, sw2)
    return out.reshape(B, L, D)


def setup_inputs(seed: int = 0) -> dict:
    key = jax.random.key(seed)
    ks = iter(jax.random.split(key, 64))
    nrm = lambda shape, s: jax.random.normal(next(ks), shape, jnp.float32) * s
    uni = lambda shape, lo, hi: jax.random.uniform(next(ks), shape, jnp.float32, lo, hi)
    Lr, D = DEPTH, D_MODEL
    return {
        'x': nrm((BATCH, SEQ, D), 1.0),
        'c': nrm((BATCH, D), 1.0),
        'w_mod': nrm((Lr, D, 6 * D), 0.5 * D ** -0.5),
        'b_mod': nrm((Lr, 6 * D), 0.01),
        'w_in': nrm((Lr, D, P_IN), D ** -0.5),
        'rwkv_mu': uni((Lr, N_RWKV_COLS), 0.0, 1.0),
        'rwkv_w0': uni((Lr, RWKV_W), -6.0, 0.0),
        'rwkv_w2': nrm((Lr, DECAY_LORA, RWKV_W), 0.5 * DECAY_LORA ** -0.5),
        'rwkv_a0': nrm((Lr, RWKV_W), 0.1),
        'rwkv_a2': nrm((Lr, AAA_LORA, RWKV_W), AAA_LORA ** -0.5),
        'rwkv_g2': nrm((Lr, GATE_LORA, RWKV_W), GATE_LORA ** -0.5),
        'rwkv_k_k': 0.85 + nrm((Lr, RWKV_W), 0.05),
        'rwkv_k_a': 1.0 + nrm((Lr, RWKV_W), 0.05),
        'rwkv_r_k': nrm((Lr, RWKV_HEADS, HEAD_DIM), 0.1),
        'rwkv_ln_g': 1.0 + nrm((Lr, RWKV_W), 0.02),
        'rwkv_ln_b': nrm((Lr, RWKV_W), 0.02),
        'dsa_kv_norm': 1.0 + nrm((Lr, KV_LORA), 0.02),
        'dsa_w_uk': nrm((Lr, DSA_HEADS, HEAD_DIM, KV_LORA), HEAD_DIM ** -0.5),
        'dsa_w_uv': nrm((Lr, DSA_HEADS, KV_LORA, HEAD_DIM), KV_LORA ** -0.5),
        'dsa_ik_g': 1.0 + nrm((Lr, IDX_DIM), 0.02),
        'dsa_ik_b': nrm((Lr, IDX_DIM), 0.02),
        'swa_sinks': nrm((Lr, SWA_HEADS), 1.0),
        'w_out': nrm((Lr, D, D), BETA * D ** -0.5),
        'ln_mix_g': 1.0 + nrm((Lr, D), 0.02),
        'ln_mix_b': nrm((Lr, D), 0.02),
        'router_w': nrm((Lr, D, N_EXPERTS), D ** -0.5),
        'router_bias': nrm((Lr, N_EXPERTS), 0.01),
        'exp_w1': nrm((Lr, N_EXPERTS, D, D_EXPERT), D ** -0.5),
        'exp_w3': nrm((Lr, N_EXPERTS, D, D_EXPERT), D ** -0.5),
        'exp_w2': nrm((Lr, N_EXPERTS, D_EXPERT, D), BETA * D_EXPERT ** -0.5),
        'sh_w1': nrm((Lr, D, D_EXPERT), D ** -0.5),
        'sh_w3': nrm((Lr, D, D_EXPERT), D ** -0.5),
        'sh_w2': nrm((Lr, D_EXPERT, D), BETA * D_EXPERT ** -0.5),
        'ln_ffn_g': 1.0 + nrm((Lr, D), 0.02),
        'ln_ffn_b': nrm((Lr, D), 0.02),
    }


def reference(x, c, w_mod, b_mod, w_in, rwkv_mu, rwkv_w0, rwkv_w2, rwkv_a0, rwkv_a2, rwkv_g2,
              rwkv_k_k, rwkv_k_a, rwkv_r_k, rwkv_ln_g, rwkv_ln_b, dsa_kv_norm, dsa_w_uk, dsa_w_uv,
              dsa_ik_g, dsa_ik_b, swa_sinks, w_out, ln_mix_g, ln_mix_b, router_w, router_bias,
              exp_w1, exp_w3, exp_w2, sh_w1, sh_w3, sh_w2, ln_ffn_g, ln_ffn_b):
    slopes = alibi_slopes(SWA_HEADS + DSA_HEADS)
    swa_slopes = slopes[:SWA_HEADS]
    dsa_slopes = slopes[SWA_HEADS:]
    cond = jax.nn.silu(c)
    for l in range(DEPTH):
        mod = cond @ w_mod[l] + b_mod[l]
        sh1, sc1, g1, sh2, sc2, g2 = [m[:, None, :] for m in jnp.split(mod, 6, axis=-1)]
        h = x * (1 + sc1) + sh1
        proj = h @ w_in[l]
        p_rwkv, p_dsa, p_swa = split_cols(proj, (N_RWKV_COLS, N_DSA_COLS, N_SWA_COLS))
        mixed = jnp.concatenate([
            rwkv7_mix(p_rwkv, rwkv_mu[l], rwkv_w0[l], rwkv_w2[l], rwkv_a0[l], rwkv_a2[l], rwkv_g2[l],
                      rwkv_k_k[l], rwkv_k_a[l], rwkv_r_k[l], rwkv_ln_g[l], rwkv_ln_b[l]),
            dsa_mix(p_dsa, dsa_kv_norm[l], dsa_w_uk[l], dsa_w_uv[l], dsa_ik_g[l], dsa_ik_b[l], dsa_slopes),
            swa_mix(p_swa, swa_sinks[l], swa_slopes),
        ], axis=-1)
        x = layer_norm(ALPHA * x + g1 * (mixed @ w_out[l]), ln_mix_g[l], ln_mix_b[l])
        h = x * (1 + sc2) + sh2
        y = moe_ffn(h, router_w[l], router_bias[l], exp_w1[l], exp_w3[l], exp_w2[l],
                    sh_w1[l], sh_w3[l], sh_w2[l])
        x = layer_norm(ALPHA * x + g2 * y, ln_ffn_g[l], ln_ffn_b[l])
    return x
```

```cpp
#include <hip/hip_runtime.h>
#include <hip/hip_cooperative_groups.h>
#include <cstdio>
#include <cstdint>
namespace cg = cooperative_groups;

constexpr int L = 16384, D = 1024, DEPTH = 4;
constexpr int HD = 64;
constexpr int RW = 384, DSW = 256, SWW = 384;
constexpr int NRWC = 1408, NDSC = 708, NSWC = 640, PIN = 2756;
constexpr int C_R = 0, C_K = 384, C_V = 768, C_WL = 1152, C_AL = 1216, C_GL = 1280;
constexpr int C_DQ = 1408, C_CKV = 1664, C_IQ = 1792, C_IK = 2048, C_IW = 2112;
constexpr int C_SQ = 2116, C_SK = 2500, C_SV = 2628;
constexpr int KVL = 128, TOPK = 256;
constexpr int NE = 64, TOPE = 8, DE = 256;
constexpr int MT = 64;
constexpr int CAP = L * TOPE + NE * MT;
constexpr int MAXTILES = CAP / MT;
constexpr float ALPHA = 1.681792830507429f;
constexpr float LN_EPS = 1e-5f, GN_EPS = 64e-5f;
constexpr int SCH = 1024;

typedef float f32x4 __attribute__((ext_vector_type(4)));

struct P {
  const float *x, *c, *w_mod, *b_mod, *w_in, *rwkv_mu, *rwkv_w0, *rwkv_w2, *rwkv_a0, *rwkv_a2, *rwkv_g2;
  const float *rwkv_k_k, *rwkv_k_a, *rwkv_r_k, *rwkv_ln_g, *rwkv_ln_b, *dsa_kv_norm, *dsa_w_uk, *dsa_w_uv;
  const float *dsa_ik_g, *dsa_ik_b, *swa_sinks, *w_out, *ln_mix_g, *ln_mix_b, *router_w, *router_bias;
  const float *exp_w1, *exp_w3, *exp_w2, *sh_w1, *sh_w3, *sh_w2, *ln_ffn_g, *ln_ffn_b;
  float* out;
  float *mod, *h, *proj, *rw_r, *rw_w, *rw_k, *rw_v, *rw_kk, *rw_b, *rw_g, *rw_bonus, *rw_y;
  float *ckv, *qlat, *ikn, *iws, *scores, *mixed, *tmp, *xa, *xb, *logits, *gate, *slot_gate, *hid, *hid_sh;
  int *idx, *eidx, *erank, *pos, *cnt, *offs, *tile_e, *ntm, *slot_tok;
  unsigned short* osort;
};

__device__ __forceinline__ float wave_sum(float v) {
#pragma unroll
  for (int o = 32; o > 0; o >>= 1) v += __shfl_xor(v, o);
  return v;
}
__device__ __forceinline__ float wave_max(float v) {
#pragma unroll
  for (int o = 32; o > 0; o >>= 1) v = fmaxf(v, __shfl_xor(v, o));
  return v;
}
__device__ __forceinline__ float sigmoidf_(float x) { return 1.0f / (1.0f + expf(-x)); }
__device__ __forceinline__ float siluf_(float x) { return x / (1.0f + expf(-x)); }
__device__ __forceinline__ float softplusf_(float x) { return fmaxf(x, 0.f) + log1pf(expf(-fabsf(x))); }
__device__ __forceinline__ unsigned short f2bf(float f) {
  unsigned u = __float_as_uint(f);
  u += 0x7fffu + ((u >> 16) & 1u);
  return (unsigned short)(u >> 16);
}
__device__ __forceinline__ float bf2f(unsigned short h) { return __uint_as_float(((unsigned)h) << 16); }

__device__ void ph_mod(const P& p, int bid, int nb, char* smem) {
  float* cond = (float*)smem;
  for (int i = threadIdx.x; i < D; i += 256) cond[i] = siluf_(p.c[i]);
  __syncthreads();
  for (int i = bid * 256 + threadIdx.x; i < DEPTH * 6 * D; i += nb * 256) {
    int l = i / (6 * D), j = i % (6 * D);
    const float* w = p.w_mod + (size_t)l * D * 6 * D + j;
    float s = 0.f;
    for (int k = 0; k < D; ++k) s += cond[k] * w[(size_t)k * 6 * D];
    p.mod[i] = s + p.b_mod[i];
  }
}

__device__ void ph_hmod(const P& p, const float* x, const float* sh, const float* sc, float* h, int bid, int nb) {
  for (size_t i = (size_t)bid * 256 + threadIdx.x; i < (size_t)L * D / 4; i += (size_t)nb * 256) {
    int c4 = (int)(i % (D / 4)) * 4;
    f32x4 v = *(const f32x4*)(x + i * 4);
    f32x4 s = *(const f32x4*)(sc + c4), b = *(const f32x4*)(sh + c4);
    f32x4 o;
    o.x = v.x * (1.f + s.x) + b.x; o.y = v.y * (1.f + s.y) + b.y; o.z = v.z * (1.f + s.z) + b.z; o.w = v.w * (1.f + s.w) + b.w;
    *(f32x4*)(h + i * 4) = o;
  }
}

struct GemmArgs {
  const float* A; const int* rowidx; const float* B; const float* B2; const int* tile_e;
  float* C; unsigned short* Cbf; const float* rowscale; const int* ntm_ptr;
  long bstride; int lda, ldb, ldc, M, N, K, epi, pad;
};
template <bool DUAL>
__device__ void ph_gemm(const GemmArgs& g, int bid, int nb, char* smem) {
  float (*As)[80] = (float (*)[80])smem;
  float (*Bs)[80] = (float (*)[80])(smem + 16 * 80 * 4);
  float (*Bs2)[80] = (float (*)[80])(smem + 2 * 16 * 80 * 4);
  const int tid = threadIdx.x, lane = tid & 63, w = tid >> 6, wm = w >> 1, wn = w & 1;
  const int ntm = g.ntm_ptr ? *g.ntm_ptr : g.M / 64;
  const int ntn = (g.N + 63) / 64;
  const int lr = lane & 15, lq = lane >> 4;
  for (int tile = bid; tile < ntm * ntn; tile += nb) {
    const int mt = tile / ntn, nt = tile % ntn;
    const int m0 = mt * 64, n0 = nt * 64;
    const float* B = g.B; const float* B2 = g.B2;
    if (g.tile_e) { long off = (long)g.tile_e[mt] * g.bstride; B += off; if (DUAL) B2 += off; }
    f32x4 acc[2][2], acc2[2][2];
#pragma unroll
    for (int i = 0; i < 2; ++i)
#pragma unroll
      for (int j = 0; j < 2; ++j) { acc[i][j] = (f32x4){0, 0, 0, 0}; acc2[i][j] = (f32x4){0, 0, 0, 0}; }
    const int arow_l = tid >> 2, akq = (tid & 3) * 4;
    int arow = m0 + arow_l;
    if (g.rowidx) arow = g.rowidx[arow];
    const int bk = tid >> 4, bn4 = (tid & 15) * 4;
    const bool bvalid = (n0 + bn4) < g.N;
    for (int k0 = 0; k0 < g.K; k0 += 16) {
      f32x4 av = (f32x4){0, 0, 0, 0};
      if (arow >= 0) av = *(const f32x4*)(g.A + (size_t)arow * g.lda + k0 + akq);
      f32x4 bv = (f32x4){0, 0, 0, 0}, bv2 = (f32x4){0, 0, 0, 0};
      if (bvalid) {
        bv = *(const f32x4*)(B + (size_t)(k0 + bk) * g.ldb + n0 + bn4);
        if (DUAL) bv2 = *(const f32x4*)(B2 + (size_t)(k0 + bk) * g.ldb + n0 + bn4);
      }
      __syncthreads();
      As[akq + 0][arow_l] = av.x; As[akq + 1][arow_l] = av.y; As[akq + 2][arow_l] = av.z; As[akq + 3][arow_l] = av.w;
      *(f32x4*)&Bs[bk][bn4] = bv;
      if (DUAL) *(f32x4*)&Bs2[bk][bn4] = bv2;
      __syncthreads();
#pragma unroll
      for (int kk = 0; kk < 4; ++kk) {
        float a[2], b[2], b2[2];
#pragma unroll
        for (int i = 0; i < 2; ++i) a[i] = As[kk * 4 + lq][wm * 32 + i * 16 + lr];
#pragma unroll
        for (int j = 0; j < 2; ++j) { b[j] = Bs[kk * 4 + lq][wn * 32 + j * 16 + lr]; if (DUAL) b2[j] = Bs2[kk * 4 + lq][wn * 32 + j * 16 + lr]; }
#pragma unroll
        for (int i = 0; i < 2; ++i)
#pragma unroll
          for (int j = 0; j < 2; ++j) {
            acc[i][j] = __builtin_amdgcn_mfma_f32_16x16x4f32(a[i], b[j], acc[i][j], 0, 0, 0);
            if (DUAL) acc2[i][j] = __builtin_amdgcn_mfma_f32_16x16x4f32(a[i], b2[j], acc2[i][j], 0, 0, 0);
          }
      }
    }
#pragma unroll
    for (int i = 0; i < 2; ++i)
#pragma unroll
      for (int j = 0; j < 2; ++j)
#pragma unroll
        for (int r = 0; r < 4; ++r) {
          const int row = m0 + wm * 32 + i * 16 + lq * 4 + r, col = n0 + wn * 32 + j * 16 + lr;
          if (col < g.N) {
            float v = acc[i][j][r];
            if (g.epi == 0) g.C[(size_t)row * g.ldc + col] = v;
            else if (g.epi == 1) g.C[(size_t)row * g.ldc + col] = siluf_(v) * acc2[i][j][r];
            else g.Cbf[(size_t)row * g.ldc + col] = f2bf(v * g.rowscale[row]);
          }
        }
  }
}

__device__ void ph_rwkv_pre(const P& p, int l, int bid, int nb, char* smem) {
  float* lora = (float*)smem;
  const int tid = threadIdx.x, lane = tid & 63, w = tid >> 6;
  const float* mu = p.rwkv_mu + (size_t)l * NRWC;
  const float* w0 = p.rwkv_w0 + (size_t)l * RW; const float* w2 = p.rwkv_w2 + (size_t)l * 64 * RW;
  const float* a0 = p.rwkv_a0 + (size_t)l * RW; const float* a2 = p.rwkv_a2 + (size_t)l * 64 * RW;
  const float* g2 = p.rwkv_g2 + (size_t)l * 128 * RW;
  const float* k_k = p.rwkv_k_k + (size_t)l * RW; const float* k_a = p.rwkv_k_a + (size_t)l * RW;
  const float* r_k = p.rwkv_r_k + (size_t)l * RW;
  for (int t = bid; t < L; t += nb) {
    const float* cur = p.proj + (size_t)t * PIN;
    const float* prv = cur - PIN;
    auto mix = [&](int col) -> float {
      float cv = cur[col];
      float pv = (t > 0) ? prv[col] : 0.f;
      return cv + (pv - cv) * mu[col];
    };
    __syncthreads();
    {
      float v = mix(C_WL + tid);
      if (tid < 64) v = tanhf(v);
      else if (tid >= 128) v = sigmoidf_(v);
      lora[tid] = v;
    }
    __syncthreads();
    for (int hd = w; hd < 6; hd += 4) {
      const int c = hd * 64 + lane;
      float r = mix(C_R + c), k = mix(C_K + c), v = mix(C_V + c);
      float wacc = 0.f, aacc = 0.f, gacc = 0.f;
      for (int j = 0; j < 64; ++j) { wacc += lora[j] * w2[j * RW + c]; aacc += lora[64 + j] * a2[j * RW + c]; }
      for (int j = 0; j < 128; ++j) gacc += lora[128 + j] * g2[j * RW + c];
      wacc += w0[c]; aacc += a0[c];
      float wl = -softplusf_(-wacc) - 0.5f;
      float decay = expf(-expf(wl));
      float a = sigmoidf_(aacc);
      float kkv = k * k_k[c];
      float nrm = sqrtf(wave_sum(kkv * kkv));
      float kk = kkv / fmaxf(nrm, 1e-12f);
      float k2 = k * (1.f + (a - 1.f) * k_a[c]);
      float bon = wave_sum(r * k2 * r_k[c]);
      size_t o = (size_t)t * RW + c;
      p.rw_r[o] = r; p.rw_w[o] = decay; p.rw_k[o] = k2; p.rw_v[o] = v; p.rw_kk[o] = kk; p.rw_b[o] = kk * a; p.rw_g[o] = gacc;
      if (lane == 0) p.rw_bonus[(size_t)t * 6 + hd] = bon;
    }
  }
}

__device__ __forceinline__ float red16(float v) {
  v += __shfl_xor(v, 8); v += __shfl_xor(v, 4); v += __shfl_xor(v, 2); v += __shfl_xor(v, 1);
  return v;
}
struct ScanIn { f32x4 kk, w, b, k, r; float v; };
__device__ __forceinline__ ScanIn scan_load(const P& p, int t, int coff, int voff) {
  ScanIn s; size_t o = (size_t)t * RW;
  s.kk = *(const f32x4*)(p.rw_kk + o + coff); s.w = *(const f32x4*)(p.rw_w + o + coff); s.b = *(const f32x4*)(p.rw_b + o + coff);
  s.k = *(const f32x4*)(p.rw_k + o + coff); s.r = *(const f32x4*)(p.rw_r + o + coff); s.v = p.rw_v[o + voff];
  return s;
}
__device__ void ph_rwkv_scan(const P& p, int bid, int nb) {
  const int tid = threadIdx.x, lane = tid & 63, w = tid >> 6;
  for (int item = bid; item < 24; item += nb) {
    const int hd = item >> 2, vg = item & 3;
    const int vrow = vg * 16 + w * 4 + (lane >> 4), kg = lane & 15;
    const int coff = hd * 64 + kg * 4, voff = hd * 64 + vrow;
    f32x4 S = (f32x4){0, 0, 0, 0};
    ScanIn buf[4];
#pragma unroll
    for (int u = 0; u < 4; ++u) buf[u] = scan_load(p, u, coff, voff);
    for (int t0 = 0; t0 < L; t0 += 4) {
#pragma unroll
      for (int u = 0; u < 4; ++u) {
        ScanIn cu = buf[u];
        if (t0 + u + 4 < L) buf[u] = scan_load(p, t0 + u + 4, coff, voff);
        float pd = S.x * cu.kk.x + S.y * cu.kk.y + S.z * cu.kk.z + S.w * cu.kk.w;
        float sa = -red16(pd);
        S.x = S.x * cu.w.x + sa * cu.b.x + cu.v * cu.k.x;
        S.y = S.y * cu.w.y + sa * cu.b.y + cu.v * cu.k.y;
        S.z = S.z * cu.w.z + sa * cu.b.z + cu.v * cu.k.z;
        S.w = S.w * cu.w.w + sa * cu.b.w + cu.v * cu.k.w;
        float y = red16(S.x * cu.r.x + S.y * cu.r.y + S.z * cu.r.z + S.w * cu.r.w);
        if (kg == 0) p.rw_y[(size_t)(t0 + u) * RW + voff] = y;
      }
    }
  }
}

__device__ void ph_rwkv_post(const P& p, int l, int bid, int nb) {
  const int tid = threadIdx.x, lane = tid & 63, w = tid >> 6;
  const float* lg = p.rwkv_ln_g + (size_t)l * RW; const float* lb = p.rwkv_ln_b + (size_t)l * RW;
  for (int item = bid * 4 + w; item < L * 6; item += nb * 4) {
    const int t = item / 6, hd = item % 6, c = hd * 64 + lane;
    size_t o = (size_t)t * RW + c;
    float y = p.rw_y[o];
    float mean = wave_sum(y) * (1.f / 64.f);
    float d = y - mean;
    float var = wave_sum(d * d) * (1.f / 64.f);
    float on = d * rsqrtf(var + GN_EPS) * lg[c] + lb[c];
    float res = (on + p.rw_bonus[(size_t)t * 6 + hd] * p.rw_v[o]) * p.rw_g[o];
    p.mixed[(size_t)t * D + c] = res;
  }
}

__device__ void ph_dsa_pre(const P& p, int l, int bid, int nb, char* smem) {
  float* q = (float*)smem;
  const int tid = threadIdx.x, lane = tid & 63, w = tid >> 6;
  const float* kvn = p.dsa_kv_norm + (size_t)l * KVL;
  const float* ikg = p.dsa_ik_g + (size_t)l * 64; const float* ikb = p.dsa_ik_b + (size_t)l * 64;
  const float* wuk = p.dsa_w_uk + (size_t)l * 4 * 64 * KVL;
  for (int t = bid; t < L; t += nb) {
    const float* cur = p.proj + (size_t)t * PIN;
    __syncthreads();
    q[tid] = cur[C_DQ + tid];
    if (w == 0) {
      float a = cur[C_CKV + lane], b = cur[C_CKV + 64 + lane];
      float ms = wave_sum(a * a + b * b) * (1.f / 128.f);
      float rs = rsqrtf(ms + 1e-6f);
      p.ckv[(size_t)t * KVL + lane] = a * rs * kvn[lane];
      p.ckv[(size_t)t * KVL + 64 + lane] = b * rs * kvn[64 + lane];
    } else if (w == 1) {
      float a = cur[C_IK + lane];
      float mean = wave_sum(a) * (1.f / 64.f);
      float d = a - mean;
      float var = wave_sum(d * d) * (1.f / 64.f);
      p.ikn[(size_t)t * 64 + lane] = d * rsqrtf(var + LN_EPS) * ikg[lane] + ikb[lane];
    } else if (w == 2) {
      if (lane < 4) p.iws[(size_t)t * 4 + lane] = cur[C_IW + lane] * (1.f / 16.f);
    }
    __syncthreads();
    for (int o = tid; o < 512; o += 256) {
      const int hd = o >> 7, r = o & 127;
      float s = 0.f;
      for (int d = 0; d < 64; ++d) s += q[hd * 64 + d] * wuk[(size_t)(hd * 64 + d) * KVL + r];
      p.qlat[(size_t)t * 512 + o] = s * 0.125f;
    }
  }
}

__device__ void ph_idx_scores(const P& p, int row0, int bid, int nb, char* smem) {
  float (*As)[80] = (float (*)[80])smem;
  float (*Bs)[80] = (float (*)[80])(smem + 16 * 80 * 4);
  const int tid = threadIdx.x, lane = tid & 63, w = tid >> 6, wm = w >> 1, wn = w & 1;
  const int lr = lane & 15, lq = lane >> 4;
  const int nqt = SCH / 64;
  for (int item = bid; item < nqt * 256; item += nb) {
    const int qtl = item / 256, kt = item % 256;
    const int qt = row0 / 64 + qtl;
    if (kt > qt) continue;
    const int q0 = qt * 64, s0 = kt * 64;
    f32x4 sc[2][2];
#pragma unroll
    for (int i = 0; i < 2; ++i)
#pragma unroll
      for (int j = 0; j < 2; ++j) sc[i][j] = (f32x4){0, 0, 0, 0};
    const int arow_l = tid >> 2, akq = (tid & 3) * 4;
    for (int hd = 0; hd < 4; ++hd) {
      f32x4 acc[2][2];
#pragma unroll
      for (int i = 0; i < 2; ++i)
#pragma unroll
        for (int j = 0; j < 2; ++j) acc[i][j] = (f32x4){0, 0, 0, 0};
      for (int k0 = 0; k0 < 64; k0 += 16) {
        f32x4 av = *(const f32x4*)(p.proj + (size_t)(q0 + arow_l) * PIN + C_IQ + hd * 64 + k0 + akq);
        f32x4 bv = *(const f32x4*)(p.ikn + (size_t)(s0 + arow_l) * 64 + k0 + akq);
        __syncthreads();
        As[akq + 0][arow_l] = av.x; As[akq + 1][arow_l] = av.y; As[akq + 2][arow_l] = av.z; As[akq + 3][arow_l] = av.w;
        Bs[akq + 0][arow_l] = bv.x; Bs[akq + 1][arow_l] = bv.y; Bs[akq + 2][arow_l] = bv.z; Bs[akq + 3][arow_l] = bv.w;
        __syncthreads();
#pragma unroll
        for (int kk = 0; kk < 4; ++kk) {
          float a[2], b[2];
#pragma unroll
          for (int i = 0; i < 2; ++i) a[i] = As[kk * 4 + lq][wm * 32 + i * 16 + lr];
#pragma unroll
          for (int j = 0; j < 2; ++j) b[j] = Bs[kk * 4 + lq][wn * 32 + j * 16 + lr];
#pragma unroll
          for (int i = 0; i < 2; ++i)
#pragma unroll
            for (int j = 0; j < 2; ++j) acc[i][j] = __builtin_amdgcn_mfma_f32_16x16x4f32(a[i], b[j], acc[i][j], 0, 0, 0);
        }
      }
#pragma unroll
      for (int i = 0; i < 2; ++i)
#pragma unroll
        for (int r = 0; r < 4; ++r) {
          const int row = q0 + wm * 32 + i * 16 + lq * 4 + r;
          const float wgt = p.iws[(size_t)row * 4 + hd];
#pragma unroll
          for (int j = 0; j < 2; ++j) sc[i][j][r] += fmaxf(acc[i][j][r], 0.f) * wgt;
        }
    }
#pragma unroll
    for (int i = 0; i < 2; ++i)
#pragma unroll
      for (int j = 0; j < 2; ++j)
#pragma unroll
        for (int r = 0; r < 4; ++r) {
          const int row = q0 + wm * 32 + i * 16 + lq * 4 + r, col = s0 + wn * 32 + j * 16 + lr;
          p.scores[(size_t)(row - row0) * L + col] = sc[i][j][r];
        }
  }
}

__device__ void ph_topk(const P& p, int row0, int bid, int nb, char* smem) {
  unsigned* keys = (unsigned*)smem;
  unsigned* hist = (unsigned*)(smem + 65536);
  unsigned* misc = hist + 256;
  unsigned* tcnt = misc + 8;
  const int tid = threadIdx.x;
  for (int rl = bid; rl < SCH; rl += nb) {
    const int t = row0 + rl, n = t + 1;
    int* out = p.idx + (size_t)t * TOPK;
    if (n <= TOPK) {
      out[tid] = (tid < n) ? tid : 0;
      continue;
    }
    __syncthreads();
    const float* srow = p.scores + (size_t)rl * L;
    for (int i = tid; i < n; i += 256) {
      unsigned u = __float_as_uint(srow[i]);
      keys[i] = (u & 0x80000000u) ? ~u : (u | 0x80000000u);
    }
    unsigned prefix = 0, mask = 0; int need = TOPK;
    for (int pass = 0; pass < 4; ++pass) {
      const int shift = 24 - 8 * pass;
      hist[tid] = 0;
      __syncthreads();
      for (int i = tid; i < n; i += 256) { unsigned k = keys[i]; if ((k & mask) == prefix) atomicAdd(&hist[(k >> shift) & 255u], 1u); }
      __syncthreads();
      if (tid == 0) {
        int cum = 0, dsel = 0;
        for (int b = 255; b >= 0; --b) { int hb = (int)hist[b]; if (cum + hb >= need) { dsel = b; break; } cum += hb; }
        misc[0] = (unsigned)dsel; misc[1] = (unsigned)(need - cum);
      }
      __syncthreads();
      prefix |= misc[0] << shift; mask |= 0xFFu << shift; need = (int)misc[1];
      __syncthreads();
    }
    const int ngt = TOPK - need;
    const int per = (n + 255) / 256;
    const int i0 = tid * per, i1 = min(n, i0 + per);
    int ceq = 0;
    for (int i = i0; i < i1; ++i) ceq += (keys[i] == prefix);
    tcnt[tid] = (unsigned)ceq;
    if (tid == 0) misc[2] = 0;
    __syncthreads();
    if (tid == 0) { unsigned run = 0; for (int i = 0; i < 256; ++i) { unsigned c = tcnt[i]; tcnt[i] = run; run += c; } }
    __syncthreads();
    int erank = (int)tcnt[tid];
    for (int i = i0; i < i1; ++i) {
      unsigned k = keys[i];
      if (k > prefix) { unsigned ps = atomicAdd(&misc[2], 1u); out[ps] = i; }
      else if (k == prefix) { if (erank < need) out[ngt + erank] = i; ++erank; }
    }
  }
}

__device__ void ph_dsa_attn(const P& p, int l, int bid, int nb, char* smem) {
  float* ql = (float*)smem;
  int* sidx = (int*)(ql + 512);
  float* pr = (float*)(sidx + 256);
  float* ol = pr + 1024;
  const int tid = threadIdx.x, lane = tid & 63, w = tid >> 6;
  const float* wuv = p.dsa_w_uv + (size_t)l * 4 * KVL * 64;
  for (int t = bid; t < L; t += nb) {
    const int cnt = min(TOPK, t + 1);
    __syncthreads();
    ql[tid] = p.qlat[(size_t)t * 512 + tid]; ql[256 + tid] = p.qlat[(size_t)t * 512 + 256 + tid];
    const int id = (tid < cnt) ? p.idx[(size_t)t * TOPK + tid] : 0;
    sidx[tid] = id;
    __syncthreads();
    {
      float lg[4] = {0.f, 0.f, 0.f, 0.f};
      const float* crow = p.ckv + (size_t)id * KVL;
      for (int r = 0; r < KVL; r += 4) {
        f32x4 cv = *(const f32x4*)(crow + r);
#pragma unroll
        for (int hd = 0; hd < 4; ++hd)
          lg[hd] += ql[hd * 128 + r] * cv.x + ql[hd * 128 + r + 1] * cv.y + ql[hd * 128 + r + 2] * cv.z + ql[hd * 128 + r + 3] * cv.w;
      }
      const float dist = (float)(t - id);
#pragma unroll
      for (int hd = 0; hd < 4; ++hd) {
        const float slope = exp2f(-8.0f * (float)(6 + hd + 1) / 10.0f);
        pr[hd * 256 + tid] = (tid < cnt) ? (lg[hd] - slope * dist) : -INFINITY;
      }
    }
    __syncthreads();
    {
      float v[4]; float m = -INFINITY;
#pragma unroll
      for (int i = 0; i < 4; ++i) { v[i] = pr[w * 256 + lane + i * 64]; m = fmaxf(m, v[i]); }
      m = wave_max(m);
      float s = 0.f;
#pragma unroll
      for (int i = 0; i < 4; ++i) { v[i] = expf(v[i] - m); s += v[i]; }
      s = wave_sum(s);
      const float inv = 1.f / s;
#pragma unroll
      for (int i = 0; i < 4; ++i) pr[w * 256 + lane + i * 64] = v[i] * inv;
    }
    __syncthreads();
    {
      const int d = tid & 127, hp = tid >> 7;
      float a0 = 0.f, a1 = 0.f;
      for (int k = 0; k < cnt; ++k) {
        const float cv = p.ckv[(size_t)sidx[k] * KVL + d];
        a0 += pr[(hp * 2) * 256 + k] * cv; a1 += pr[(hp * 2 + 1) * 256 + k] * cv;
      }
      ol[(hp * 2) * 128 + d] = a0; ol[(hp * 2 + 1) * 128 + d] = a1;
    }
    __syncthreads();
    {
      const int hd = tid >> 6, e = tid & 63;
      float s = 0.f;
      for (int r = 0; r < KVL; ++r) s += ol[hd * 128 + r] * wuv[(size_t)(hd * KVL + r) * 64 + e];
      p.mixed[(size_t)t * D + RW + hd * 64 + e] = s;
    }
  }
}

__device__ void ph_swa(const P& p, int l, int bid, int nb, char* smem) {
  const int tid = threadIdx.x, lane = tid & 63, w = tid >> 6;
  float* qs = (float*)smem + w * 64;
  const float* sinks = p.swa_sinks + (size_t)l * 6;
  for (int item = bid * 4 + w; item < L * 6; item += nb * 4) {
    const int t = item / 6, hq = item % 6, g = hq / 3;
    qs[lane] = p.proj[(size_t)t * PIN + C_SQ + hq * 64 + lane];
    const float slope = exp2f(-8.0f * (float)(hq + 1) / 10.0f);
    float lg[2];
#pragma unroll
    for (int i = 0; i < 2; ++i) {
      const int j = lane + i * 64;
      const int s = t - 127 + j;
      float v = -INFINITY;
      if (s >= 0) {
        const float* kr = p.proj + (size_t)s * PIN + C_SK + g * 64;
        float acc = 0.f;
        for (int d = 0; d < 64; d += 4) {
          f32x4 kv = *(const f32x4*)(kr + d);
          acc += qs[d] * kv.x + qs[d + 1] * kv.y + qs[d + 2] * kv.z + qs[d + 3] * kv.w;
        }
        v = acc * 0.125f - slope * (float)(t - s);
      }
      lg[i] = v;
    }
    const float sink = sinks[hq];
    const float m = fmaxf(wave_max(fmaxf(lg[0], lg[1])), sink);
    float e0 = expf(lg[0] - m), e1 = expf(lg[1] - m);
    const float den = wave_sum(e0 + e1) + expf(sink - m);
    e0 /= den; e1 /= den;
    float acc = 0.f;
    for (int j = 0; j < 128; ++j) {
      const int s = t - 127 + j;
      const float pj = __shfl((j < 64) ? e0 : e1, j & 63);
      if (s >= 0) acc += pj * p.proj[(size_t)s * PIN + C_SV + g * 64 + lane];
    }
    p.mixed[(size_t)t * D + RW + DSW + hq * 64 + lane] = acc;
  }
}

template <bool COMBINE>
__device__ void ph_ln(const P& p, const float* xin, const float* gatev, const float* lng, const float* lnb,
                      float* xout, const float* nsh, const float* nsc, float* hout, int bid, int nb, char* smem) {
  float* red = (float*)smem;
  const int tid = threadIdx.x, lane = tid & 63, w = tid >> 6;
  const int c = tid * 4;
  for (int t = bid; t < L; t += nb) {
    f32x4 xv = *(const f32x4*)(xin + (size_t)t * D + c);
    f32x4 y = *(const f32x4*)(p.tmp + (size_t)t * D + c);
    if (COMBINE) {
      f32x4 r = (f32x4){0, 0, 0, 0};
      for (int k = 0; k < TOPE; ++k) {
        const int slot = p.pos[(size_t)t * TOPE + k];
        const unsigned short* o = p.osort + (size_t)slot * D + c;
        ushort4 ov = *(const ushort4*)o;
        r.x += bf2f(ov.x); r.y += bf2f(ov.y); r.z += bf2f(ov.z); r.w += bf2f(ov.w);
      }
      y = r + y;
    }
    f32x4 gv = *(const f32x4*)(gatev + c);
    f32x4 v = xv * ALPHA + gv * y;
    float s = wave_sum(v.x + v.y + v.z + v.w);
    __syncthreads();
    if (lane == 0) red[w] = s;
    __syncthreads();
    const float mean = (red[0] + red[1] + red[2] + red[3]) * (1.f / D);
    f32x4 d = v - mean;
    float q = wave_sum(d.x * d.x + d.y * d.y + d.z * d.z + d.w * d.w);
    if (lane == 0) red[4 + w] = q;
    __syncthreads();
    const float var = (red[4] + red[5] + red[6] + red[7]) * (1.f / D);
    const float rs = rsqrtf(var + LN_EPS);
    f32x4 gg = *(const f32x4*)(lng + c), bb = *(const f32x4*)(lnb + c);
    f32x4 o = d * rs * gg + bb;
    *(f32x4*)(xout + (size_t)t * D + c) = o;
    if (hout) {
      f32x4 sc = *(const f32x4*)(nsc + c), sh = *(const f32x4*)(nsh + c);
      *(f32x4*)(hout + (size_t)t * D + c) = o * (sc + 1.f) + sh;
    }
  }
}

__device__ void ph_route(const P& p, int l, int bid, int nb, char* smem) {
  const int tid = threadIdx.x, lane = tid & 63, w = tid >> 6;
  float* sel = (float*)smem + w * 128;
  float* gs = sel + 64;
  const float* bias = p.router_bias + (size_t)l * NE;
  int* cnt = p.cnt + l * NE;
  for (int i = bid * 256 + tid; i < CAP; i += nb * 256) p.slot_tok[i] = -1;
  for (int t = bid * 4 + w; t < L; t += nb * 4) {
    const float score = sigmoidf_(p.logits[(size_t)t * NE + lane]);
    const float sv = score + bias[lane];
    sel[lane] = sv;
    const int g = lane >> 3;
    int rg = 0;
#pragma unroll
    for (int j = 0; j < 8; ++j) { const int o = g * 8 + j; const float ov = sel[o]; rg += (ov > sv || (ov == sv && o < lane)) ? 1 : 0; }
    float contrib = (rg < 2) ? sv : 0.f;
    contrib += __shfl_xor(contrib, 1); contrib += __shfl_xor(contrib, 2); contrib += __shfl_xor(contrib, 4);
    if ((lane & 7) == 0) gs[g] = contrib;
    const float mygs = contrib;
    int grank = 0;
#pragma unroll
    for (int j = 0; j < 8; ++j) { const float ov = gs[j]; grank += (ov > mygs || (ov == mygs && j < g)) ? 1 : 0; }
    const float sv2 = (grank < 4) ? sv : -1e30f;
    sel[lane] = sv2;
    int rk = 0;
    for (int j = 0; j < 64; ++j) { const float ov = sel[j]; rk += (ov > sv2 || (ov == sv2 && j < lane)) ? 1 : 0; }
    const bool chosen = rk < TOPE;
    const float ssum = wave_sum(chosen ? score : 0.f);
    if (chosen) {
      const float gt = score / ssum * 2.5f;
      const int er = atomicAdd(&cnt[lane], 1);
      p.eidx[(size_t)t * TOPE + rk] = lane;
      p.gate[(size_t)t * TOPE + rk] = gt;
      p.erank[(size_t)t * TOPE + rk] = er;
    }
  }
}

__device__ void ph_moe_offsets(const P& p, int l) {
  if (threadIdx.x == 0) {
    const int* cnt = p.cnt + l * NE;
    int off = 0, nt = 0;
    for (int e = 0; e < NE; ++e) {
      p.offs[e] = off;
      const int tl = (cnt[e] + MT - 1) / MT;
      for (int i = 0; i < tl; ++i) p.tile_e[nt + i] = e;
      nt += tl; off += tl * MT;
    }
    p.offs[NE] = off;
    *p.ntm = nt;
  }
}

__device__ void ph_moe_scatter(const P& p, int bid, int nb) {
  for (int i = bid * 256 + threadIdx.x; i < L * TOPE; i += nb * 256) {
    const int e = p.eidx[i];
    const int slot = p.offs[e] + p.erank[i];
    p.slot_tok[slot] = i / TOPE;
    p.slot_gate[slot] = p.gate[i];
    p.pos[i] = slot;
  }
}

constexpr int SMEM_BYTES = 65536 + 4096;
enum { K_MOD, K_HMOD, K_GEMM, K_GEMM_DUAL, K_RWPRE, K_RWSCAN, K_RWPOST, K_DSAPRE, K_IDXSC, K_TOPK, K_DSAATT, K_SWA, K_LNMIX, K_ROUTE, K_MOEOFF, K_MOESC, K_LNFFN };

template <int PH>
__global__ void __launch_bounds__(256) kph(P p, GemmArgs g, int l, int aux) {
  __shared__ __attribute__((aligned(16))) char smem[SMEM_BYTES];
  const int bid = blockIdx.x, nb = gridDim.x;
  const float* mod = p.mod + (size_t)l * 6 * D;
  if (PH == K_MOD) ph_mod(p, bid, nb, smem);
  else if (PH == K_HMOD) ph_hmod(p, p.x, mod + 0, mod + D, p.h, bid, nb);
  else if (PH == K_GEMM) ph_gemm<false>(g, bid, nb, smem);
  else if (PH == K_GEMM_DUAL) ph_gemm<true>(g, bid, nb, smem);
  else if (PH == K_RWPRE) ph_rwkv_pre(p, l, bid, nb, smem);
  else if (PH == K_RWSCAN) ph_rwkv_scan(p, bid, nb);
  else if (PH == K_RWPOST) ph_rwkv_post(p, l, bid, nb);
  else if (PH == K_DSAPRE) ph_dsa_pre(p, l, bid, nb, smem);
  else if (PH == K_IDXSC) ph_idx_scores(p, aux, bid, nb, smem);
  else if (PH == K_TOPK) ph_topk(p, aux, bid, nb, smem);
  else if (PH == K_DSAATT) ph_dsa_attn(p, l, bid, nb, smem);
  else if (PH == K_SWA) ph_swa(p, l, bid, nb, smem);
  else if (PH == K_LNMIX) {
    const float* xin = (l == 0) ? p.x : p.xb;
    ph_ln<false>(p, xin, mod + 2 * D, p.ln_mix_g + (size_t)l * D, p.ln_mix_b + (size_t)l * D, p.xa, mod + 3 * D, mod + 4 * D, p.h, bid, nb, smem);
  } else if (PH == K_ROUTE) ph_route(p, l, bid, nb, smem);
  else if (PH == K_MOEOFF) ph_moe_offsets(p, l);
  else if (PH == K_MOESC) ph_moe_scatter(p, bid, nb);
  else if (PH == K_LNFFN) {
    const bool last = (l == DEPTH - 1);
    const float* nmod = mod + 6 * D;
    ph_ln<true>(p, p.xa, mod + 5 * D, p.ln_ffn_g + (size_t)l * D, p.ln_ffn_b + (size_t)l * D, last ? p.out : p.xb,
                nmod + 0, nmod + D, last ? nullptr : p.h, bid, nb, smem);
  }
}

static inline char* carve(char*& cur, size_t bytes) { char* r = cur; cur += (bytes + 255) & ~(size_t)255; return r; }

extern "C" void kernel_launch(void* const* d_in, const int* in_sizes, int n_in,
                              void* d_out, int out_size, void* d_ws, size_t ws_size,
                              hipStream_t stream) {
  P p{};
  const float** ins = (const float**)&p.x;
  for (int i = 0; i < 35; ++i) ins[i] = (const float*)d_in[i];
  p.out = (float*)d_out;
  char* cur = (char*)d_ws;
  p.cnt = (int*)carve(cur, DEPTH * NE * 4);
  p.offs = (int*)carve(cur, (NE + 1) * 4);
  p.ntm = (int*)carve(cur, 4);
  p.tile_e = (int*)carve(cur, MAXTILES * 4);
  p.mod = (float*)carve(cur, (size_t)(DEPTH + 1) * 6 * D * 4);
  p.h = (float*)carve(cur, (size_t)L * D * 4);
  p.mixed = (float*)carve(cur, (size_t)L * D * 4);
  p.tmp = (float*)carve(cur, (size_t)L * D * 4);
  p.xa = (float*)carve(cur, (size_t)L * D * 4);
  p.xb = (float*)carve(cur, (size_t)L * D * 4);
  p.logits = (float*)carve(cur, (size_t)L * NE * 4);
  p.gate = (float*)carve(cur, (size_t)L * TOPE * 4);
  p.eidx = (int*)carve(cur, (size_t)L * TOPE * 4);
  p.erank = (int*)carve(cur, (size_t)L * TOPE * 4);
  p.pos = (int*)carve(cur, (size_t)L * TOPE * 4);
  p.slot_tok = (int*)carve(cur, (size_t)CAP * 4);
  p.slot_gate = (float*)carve(cur, (size_t)CAP * 4);
  p.hid_sh = (float*)carve(cur, (size_t)L * DE * 4);
  char* ov = cur;
  p.proj = (float*)carve(cur, (size_t)L * PIN * 4);
  p.rw_r = (float*)carve(cur, (size_t)L * RW * 4);
  p.rw_w = (float*)carve(cur, (size_t)L * RW * 4);
  p.rw_k = (float*)carve(cur, (size_t)L * RW * 4);
  p.rw_v = (float*)carve(cur, (size_t)L * RW * 4);
  p.rw_kk = (float*)carve(cur, (size_t)L * RW * 4);
  p.rw_b = (float*)carve(cur, (size_t)L * RW * 4);
  p.rw_g = (float*)carve(cur, (size_t)L * RW * 4);
  p.rw_y = (float*)carve(cur, (size_t)L * RW * 4);
  p.rw_bonus = (float*)carve(cur, (size_t)L * 6 * 4);
  p.ckv = (float*)carve(cur, (size_t)L * KVL * 4);
  p.qlat = (float*)carve(cur, (size_t)L * 512 * 4);
  p.ikn = (float*)carve(cur, (size_t)L * 64 * 4);
  p.iws = (float*)carve(cur, (size_t)L * 4 * 4);
  p.idx = (int*)carve(cur, (size_t)L * TOPK * 4);
  p.scores = (float*)carve(cur, (size_t)SCH * L * 4);
  char* ovend = cur;
  char* cur2 = ov;
  p.hid = (float*)carve(cur2, (size_t)CAP * DE * 4);
  p.osort = (unsigned short*)carve(cur2, (size_t)CAP * D * 2);
  if (cur2 > ovend) ovend = cur2;
  if ((size_t)(ovend - (char*)d_ws) > ws_size) { fprintf(stderr, "workspace too small: need %zu have %zu\n", (size_t)(ovend - (char*)d_ws), ws_size); return; }

  hipMemsetAsync(p.cnt, 0, DEPTH * NE * 4, stream);
  GemmArgs g0{};
  const int NB = 1024;
  kph<K_MOD><<<96, 256, 0, stream>>>(p, g0, 0, 0);
  for (int l = 0; l < DEPTH; ++l) {
    if (l == 0) kph<K_HMOD><<<NB, 256, 0, stream>>>(p, g0, l, 0);
    {
      GemmArgs g{}; g.A = p.h; g.lda = D; g.B = p.w_in + (size_t)l * D * PIN; g.ldb = PIN; g.C = p.proj; g.ldc = PIN; g.M = L; g.N = PIN; g.K = D; g.epi = 0;
      kph<K_GEMM><<<2048, 256, 0, stream>>>(p, g, l, 0);
    }
    kph<K_RWPRE><<<NB, 256, 0, stream>>>(p, g0, l, 0);
    kph<K_RWSCAN><<<24, 256, 0, stream>>>(p, g0, l, 0);
    kph<K_RWPOST><<<NB, 256, 0, stream>>>(p, g0, l, 0);
    kph<K_DSAPRE><<<NB, 256, 0, stream>>>(p, g0, l, 0);
    for (int r0 = 0; r0 < L; r0 += SCH) {
      kph<K_IDXSC><<<2048, 256, 0, stream>>>(p, g0, l, r0);
      kph<K_TOPK><<<SCH, 256, 0, stream>>>(p, g0, l, r0);
    }
    kph<K_DSAATT><<<2048, 256, 0, stream>>>(p, g0, l, 0);
    kph<K_SWA><<<2048, 256, 0, stream>>>(p, g0, l, 0);
    {
      GemmArgs g{}; g.A = p.mixed; g.lda = D; g.B = p.w_out + (size_t)l * D * D; g.ldb = D; g.C = p.tmp; g.ldc = D; g.M = L; g.N = D; g.K = D; g.epi = 0;
      kph<K_GEMM><<<2048, 256, 0, stream>>>(p, g, l, 0);
    }
    kph<K_LNMIX><<<NB, 256, 0, stream>>>(p, g0, l, 0);
    {
      GemmArgs g{}; g.A = p.h; g.lda = D; g.B = p.router_w + (size_t)l * D * NE; g.ldb = NE; g.C = p.logits; g.ldc = NE; g.M = L; g.N = NE; g.K = D; g.epi = 0;
      kph<K_GEMM><<<256, 256, 0, stream>>>(p, g, l, 0);
    }
    kph<K_ROUTE><<<NB, 256, 0, stream>>>(p, g0, l, 0);
    kph<K_MOEOFF><<<1, 256, 0, stream>>>(p, g0, l, 0);
    kph<K_MOESC><<<512, 256, 0, stream>>>(p, g0, l, 0);
    {
      GemmArgs g{}; g.A = p.h; g.lda = D; g.rowidx = p.slot_tok; g.B = p.exp_w1 + (size_t)l * NE * D * DE; g.B2 = p.exp_w3 + (size_t)l * NE * D * DE;
      g.bstride = (long)D * DE; g.tile_e = p.tile_e; g.ldb = DE; g.C = p.hid; g.ldc = DE; g.M = CAP; g.N = DE; g.K = D; g.epi = 1; g.ntm_ptr = p.ntm;
      kph<K_GEMM_DUAL><<<2048, 256, 0, stream>>>(p, g, l, 0);
    }
    {
      GemmArgs g{}; g.A = p.hid; g.lda = DE; g.B = p.exp_w2 + (size_t)l * NE * DE * D; g.bstride = (long)DE * D; g.tile_e = p.tile_e; g.ldb = D;
      g.Cbf = p.osort; g.ldc = D; g.M = CAP; g.N = D; g.K = DE; g.epi = 2; g.rowscale = p.slot_gate; g.ntm_ptr = p.ntm;
      kph<K_GEMM><<<2048, 256, 0, stream>>>(p, g, l, 0);
    }
    {
      GemmArgs g{}; g.A = p.h; g.lda = D; g.B = p.sh_w1 + (size_t)l * D * DE; g.B2 = p.sh_w3 + (size_t)l * D * DE; g.ldb = DE; g.C = p.hid_sh; g.ldc = DE;
      g.M = L; g.N = DE; g.K = D; g.epi = 1;
      kph<K_GEMM_DUAL><<<1024, 256, 0, stream>>>(p, g, l, 0);
    }
    {
      GemmArgs g{}; g.A = p.hid_sh; g.lda = DE; g.B = p.sh_w2 + (size_t)l * DE * D; g.ldb = D; g.C = p.tmp; g.ldc = D; g.M = L; g.N = D; g.K = DE; g.epi = 0;
      kph<K_GEMM><<<2048, 256, 0, stream>>>(p, g, l, 0);
    }
    kph<K_LNFFN><<<NB, 256, 0, stream>>>(p, g0, l, 0);
  }
}
```

```cpp
#include <hip/hip_runtime.h>
#include <hip/hip_cooperative_groups.h>
#include <cstdio>
#include <cstdint>
namespace cg = cooperative_groups;

constexpr int L = 16384, D = 1024, DEPTH = 4;
constexpr int RW = 384, DSW = 256, SWW = 384;
constexpr int NRWC = 1408, PIN = 2756, PINP = 2816;
constexpr int C_R = 0, C_K = 384, C_V = 768, C_WL = 1152, C_AL = 1216, C_GL = 1280;
constexpr int C_DQ = 1408, C_CKV = 1664, C_IQ = 1792, C_IK = 2048, C_IW = 2112;
constexpr int C_SQ = 2116, C_SK = 2500, C_SV = 2628;
constexpr int KVL = 128, TOPK = 256;
constexpr int NE = 64, NEX = 65, TOPE = 8, DE = 256;
constexpr int MT = 128;
constexpr int CAPR = L * TOPE + NE * MT;
constexpr int CAP = CAPR + L;
constexpr int MAXTILES = CAP / MT;
constexpr float ALPHA = 1.681792830507429f;
constexpr float LN_EPS = 1e-5f, GN_EPS = 64e-5f;
constexpr int NQT = L / 128;
constexpr int KCH = 8;

typedef float f32x4 __attribute__((ext_vector_type(4)));
typedef short bf16x8 __attribute__((ext_vector_type(8)));
typedef unsigned short bf16_t;
#define LDSP __attribute__((address_space(3)))

struct P {
  const float *x, *c, *w_mod, *b_mod, *w_in, *rwkv_mu, *rwkv_w0, *rwkv_w2, *rwkv_a0, *rwkv_a2, *rwkv_g2;
  const float *rwkv_k_k, *rwkv_k_a, *rwkv_r_k, *rwkv_ln_g, *rwkv_ln_b, *dsa_kv_norm, *dsa_w_uk, *dsa_w_uv;
  const float *dsa_ik_g, *dsa_ik_b, *swa_sinks, *w_out, *ln_mix_g, *ln_mix_b, *router_w, *router_bias;
  const float *exp_w1, *exp_w3, *exp_w2, *sh_w1, *sh_w3, *sh_w2, *ln_ffn_g, *ln_ffn_b;
  float* out;
  float *mod, *hf, *rw_r, *rw_w, *rw_k, *rw_v, *rw_kk, *rw_b, *rw_g, *rw_bonus, *rw_y;
  float *ckv, *qlat, *iws, *tmp, *xa, *xb, *logits, *gate, *slot_gate;
  int *idx, *eidx, *erank, *pos, *cnt, *offs, *tile_e, *ntm, *slot_tok;
  bf16_t *h, *proj, *mixed, *ikn, *hid, *osort, *keys, *wb_in, *wb_out, *wb_up, *wb_dn;
};

__device__ __forceinline__ int otid() { int t = (int)__builtin_amdgcn_workitem_id_x(); asm volatile("" : "+v"(t)); return t; }
__device__ __forceinline__ float wave_sum(float v) {
#pragma unroll
  for (int o = 32; o > 0; o >>= 1) v += __shfl_xor(v, o);
  return v;
}
__device__ __forceinline__ float wave_max(float v) {
#pragma unroll
  for (int o = 32; o > 0; o >>= 1) v = fmaxf(v, __shfl_xor(v, o));
  return v;
}
__device__ __forceinline__ float sigmoidf_(float x) { return 1.0f / (1.0f + expf(-x)); }
__device__ __forceinline__ float siluf_(float x) { return x / (1.0f + expf(-x)); }
__device__ __forceinline__ float softplusf_(float x) { return fmaxf(x, 0.f) + log1pf(expf(-fabsf(x))); }
__device__ __forceinline__ bf16_t f2bf(float f) {
  unsigned u = __float_as_uint(f);
  u += 0x7fffu + ((u >> 16) & 1u);
  return (bf16_t)(u >> 16);
}
__device__ __forceinline__ float bf2f(bf16_t h) { return __uint_as_float(((unsigned)h) << 16); }
__device__ __forceinline__ unsigned pack2(float a, float b) { return (unsigned)f2bf(a) | ((unsigned)f2bf(b) << 16); }

__device__ void ph_mod(const P& p, int bid, int nb, char* smem) {
  float* cond = (float*)smem;
  for (int i = otid(); i < D; i += 256) cond[i] = siluf_(p.c[i]);
  __syncthreads();
  for (int i = bid * 256 + otid(); i < DEPTH * 6 * D; i += nb * 256) {
    int l = i / (6 * D), j = i % (6 * D);
    const float* w = p.w_mod + (size_t)l * D * 6 * D + j;
    float s = 0.f;
    for (int k = 0; k < D; ++k) s += cond[k] * w[(size_t)k * 6 * D];
    p.mod[i] = s + p.b_mod[i];
  }
}

__device__ void ph_hmod(const P& p, const float* x, const float* sh, const float* sc, bf16_t* h, int bid, int nb) {
  for (size_t i = (size_t)bid * 256 + otid(); i < (size_t)L * D / 4; i += (size_t)nb * 256) {
    int c4 = (int)(i % (D / 4)) * 4;
    f32x4 v = *(const f32x4*)(x + i * 4);
    f32x4 s = *(const f32x4*)(sc + c4), b = *(const f32x4*)(sh + c4);
    f32x4 o = v * (s + 1.f) + b;
    uint2 pk; pk.x = pack2(o.x, o.y); pk.y = pack2(o.z, o.w);
    *(uint2*)(h + i * 4) = pk;
  }
  for (int i = bid * 256 + otid(); i < D; i += nb * 256) h[(size_t)L * D + i] = 0;
}

__device__ void conv_tile(bf16_t* dst, int K, const float* src0, const float* src1, int ld, int mode, int nvalid, int nt, int kt, float (*t)[65]) {
  const int tid = otid();
  const int n0 = nt * 64, k0 = kt * 64;
  __syncthreads();
  for (int i = tid; i < 4096; i += 256) {
    const int kk = i >> 6, nn = i & 63;
    float v = 0.f;
    if (mode == 0) { const int col = n0 + nn; if (col < nvalid) v = src0[(size_t)(k0 + kk) * ld + col]; }
    else { const int col = (n0 >> 6) * 32 + (nn & 31); v = ((nn < 32) ? src0 : src1)[(size_t)(k0 + kk) * ld + col]; }
    t[kk][nn] = v;
  }
  __syncthreads();
  for (int i = tid; i < 2048; i += 256) {
    const int nn = i >> 5, k2 = (i & 31) * 2;
    *(unsigned*)(dst + (size_t)(n0 + nn) * K + k0 + k2) = pack2(t[k2][nn], t[k2 + 1][nn]);
  }
}
__device__ void ph_convert(const P& p, int l, int bid, int nb, char* smem) {
  float (*t)[65] = (float (*)[65])smem;
  constexpr int T_IN = (PINP / 64) * (D / 64), T_OUT = (D / 64) * (D / 64), T_UP = (512 / 64) * (D / 64), T_DN = (D / 64) * (DE / 64);
  constexpr int TOT = T_IN + T_OUT + NEX * T_UP + NEX * T_DN;
  for (int job = bid; job < TOT; job += nb) {
    int j = job;
    if (j < T_IN) { conv_tile(p.wb_in, D, p.w_in + (size_t)l * D * PIN, nullptr, PIN, 0, PIN, j / (D / 64), j % (D / 64), t); continue; }
    j -= T_IN;
    if (j < T_OUT) { conv_tile(p.wb_out, D, p.w_out + (size_t)l * D * D, nullptr, D, 0, D, j / (D / 64), j % (D / 64), t); continue; }
    j -= T_OUT;
    if (j < NEX * T_UP) {
      const int e = j / T_UP, r = j % T_UP;
      const float* s1 = (e < NE) ? p.exp_w1 + ((size_t)l * NE + e) * D * DE : p.sh_w1 + (size_t)l * D * DE;
      const float* s3 = (e < NE) ? p.exp_w3 + ((size_t)l * NE + e) * D * DE : p.sh_w3 + (size_t)l * D * DE;
      conv_tile(p.wb_up + (size_t)e * 512 * D, D, s1, s3, DE, 1, 0, r / (D / 64), r % (D / 64), t);
      continue;
    }
    j -= NEX * T_UP;
    {
      const int e = j / T_DN, r = j % T_DN;
      const float* s2 = (e < NE) ? p.exp_w2 + ((size_t)l * NE + e) * DE * D : p.sh_w2 + (size_t)l * DE * D;
      conv_tile(p.wb_dn + (size_t)e * D * DE, DE, s2, nullptr, D, 0, D, r / (DE / 64), r % (DE / 64), t);
    }
  }
}

struct BG {
  const bf16_t* A; const int* rowidx; const bf16_t* Bt; const int* tile_e; const int* ntm_ptr;
  void* C; const float* rowscale;
  long bstride; int lda, K, ldc, ntm, ntn, pad;
};
__device__ __forceinline__ void glds16(const void* g, LDSP void* l) {
  __builtin_amdgcn_global_load_lds((const unsigned*)g, (LDSP unsigned*)l, 16, 0, 0);
}
template <int EPI>
__device__ void ph_bgemm(const BG& g, int bid, int nb, char* smem) {
  LDSP char* lds = (LDSP char*)smem;
  const int tid = otid(), lane = tid & 63, w = tid >> 6, wr = w >> 1, wc = w & 1;
  const int fr = lane & 15, fq = lane >> 4;
  const int ntm = g.ntm_ptr ? *g.ntm_ptr : g.ntm;
  const int ntn = g.ntn, nk = g.K / 64;
  const int srow = tid >> 3, c16 = (tid & 7) ^ (srow & 7);
  const int x7 = fr & 7;
  for (int tile = bid; tile < ntm * ntn; tile += nb) {
    const int mt = tile / ntn, nt = tile % ntn;
    const int m0 = mt * 128, n0 = nt * 128;
    const bf16_t* Bt = g.Bt;
    if (g.tile_e) Bt += (long)g.tile_e[mt] * g.bstride;
    const bf16_t* ap[4]; const bf16_t* bp[4];
#pragma unroll
    for (int i = 0; i < 4; ++i) {
      int ar = m0 + i * 32 + srow;
      if (g.rowidx) ar = g.rowidx[ar];
      ap[i] = g.A + (size_t)ar * g.lda + c16 * 8;
      bp[i] = Bt + (size_t)(n0 + i * 32 + srow) * g.K + c16 * 8;
    }
    f32x4 acc[4][4];
#pragma unroll
    for (int i = 0; i < 4; ++i)
#pragma unroll
      for (int j = 0; j < 4; ++j) acc[i][j] = (f32x4){0, 0, 0, 0};
#pragma unroll
    for (int i = 0; i < 4; ++i) {
      glds16(ap[i], lds + (i * 256 + tid) * 16);
      glds16(bp[i], lds + 16384 + (i * 256 + tid) * 16);
    }
    asm volatile("s_waitcnt vmcnt(0)" ::: "memory");
    __syncthreads();
    for (int kt = 0; kt < nk; ++kt) {
      const int cur = kt & 1;
      if (kt + 1 < nk) {
        LDSP char* nb_ = lds + (cur ^ 1) * 32768;
#pragma unroll
        for (int i = 0; i < 4; ++i) {
          glds16(ap[i] + (kt + 1) * 64, nb_ + (i * 256 + tid) * 16);
          glds16(bp[i] + (kt + 1) * 64, nb_ + 16384 + (i * 256 + tid) * 16);
        }
      }
      LDSP char* la = lds + cur * 32768;
      LDSP char* lb = la + 16384;
#pragma unroll
      for (int ks = 0; ks < 2; ++ks) {
        bf16x8 af[4], bfv[4];
        const int sw = ((ks * 4 + fq) ^ x7) << 4;
#pragma unroll
        for (int i = 0; i < 4; ++i) {
          af[i] = *(LDSP const bf16x8*)(la + (wr * 64 + i * 16 + fr) * 128 + sw);
          bfv[i] = *(LDSP const bf16x8*)(lb + (wc * 64 + i * 16 + fr) * 128 + sw);
        }
#pragma unroll
        for (int i = 0; i < 4; ++i)
#pragma unroll
          for (int j = 0; j < 4; ++j) acc[i][j] = __builtin_amdgcn_mfma_f32_16x16x32_bf16(bfv[j], af[i], acc[i][j], 0, 0, 0);
      }
      asm volatile("s_waitcnt vmcnt(0)" ::: "memory");
      __syncthreads();
    }
#pragma unroll
    for (int i = 0; i < 4; ++i) {
      const int row = m0 + wr * 64 + i * 16 + fr;
      if (EPI == 0) {
        bf16_t* C = (bf16_t*)g.C;
#pragma unroll
        for (int j = 0; j < 4; ++j) {
          uint2 pk; pk.x = pack2(acc[i][j][0], acc[i][j][1]); pk.y = pack2(acc[i][j][2], acc[i][j][3]);
          *(uint2*)(C + (size_t)row * g.ldc + n0 + wc * 64 + j * 16 + fq * 4) = pk;
        }
      } else if (EPI == 1) {
        float* C = (float*)g.C;
#pragma unroll
        for (int j = 0; j < 4; ++j) *(f32x4*)(C + (size_t)row * g.ldc + n0 + wc * 64 + j * 16 + fq * 4) = acc[i][j];
      } else if (EPI == 2) {
        bf16_t* C = (bf16_t*)g.C;
#pragma unroll
        for (int j = 0; j < 2; ++j) {
          f32x4 a = acc[i][j], b = acc[i][j + 2];
          uint2 pk; pk.x = pack2(siluf_(a[0]) * b[0], siluf_(a[1]) * b[1]); pk.y = pack2(siluf_(a[2]) * b[2], siluf_(a[3]) * b[3]);
          *(uint2*)(C + (size_t)row * g.ldc + nt * 64 + wc * 32 + j * 16 + fq * 4) = pk;
        }
      } else {
        bf16_t* C = (bf16_t*)g.C;
        const float sc = g.rowscale[row];
#pragma unroll
        for (int j = 0; j < 4; ++j) {
          uint2 pk; pk.x = pack2(acc[i][j][0] * sc, acc[i][j][1] * sc); pk.y = pack2(acc[i][j][2] * sc, acc[i][j][3] * sc);
          *(uint2*)(C + (size_t)row * g.ldc + n0 + wc * 64 + j * 16 + fq * 4) = pk;
        }
      }
    }
  }
}

__device__ void ph_router_gemm(const P& p, int l, int bid, int nb, char* smem) {
  float (*As)[80] = (float (*)[80])smem;
  float (*Bs)[80] = (float (*)[80])(smem + 16 * 80 * 4);
  const int tid = otid(), lane = tid & 63, w = tid >> 6, wm = w >> 1, wn = w & 1;
  const int lr = lane & 15, lq = lane >> 4;
  const float* B = p.router_w + (size_t)l * D * NE;
  for (int mt = bid; mt < L / 64; mt += nb) {
    const int m0 = mt * 64;
    f32x4 acc[2][2];
#pragma unroll
    for (int i = 0; i < 2; ++i)
#pragma unroll
      for (int j = 0; j < 2; ++j) acc[i][j] = (f32x4){0, 0, 0, 0};
    const int arow_l = tid >> 2, akq = (tid & 3) * 4;
    const int bk = tid >> 4, bn4 = (tid & 15) * 4;
    for (int k0 = 0; k0 < D; k0 += 16) {
      f32x4 av = *(const f32x4*)(p.hf + (size_t)(m0 + arow_l) * D + k0 + akq);
      f32x4 bv = *(const f32x4*)(B + (size_t)(k0 + bk) * NE + bn4);
      __syncthreads();
      As[akq + 0][arow_l] = av.x; As[akq + 1][arow_l] = av.y; As[akq + 2][arow_l] = av.z; As[akq + 3][arow_l] = av.w;
      *(f32x4*)&Bs[bk][bn4] = bv;
      __syncthreads();
#pragma unroll
      for (int kk = 0; kk < 4; ++kk) {
        float a[2], b[2];
#pragma unroll
        for (int i = 0; i < 2; ++i) a[i] = As[kk * 4 + lq][wm * 32 + i * 16 + lr];
#pragma unroll
        for (int j = 0; j < 2; ++j) b[j] = Bs[kk * 4 + lq][wn * 32 + j * 16 + lr];
#pragma unroll
        for (int i = 0; i < 2; ++i)
#pragma unroll
          for (int j = 0; j < 2; ++j) acc[i][j] = __builtin_amdgcn_mfma_f32_16x16x4f32(a[i], b[j], acc[i][j], 0, 0, 0);
      }
    }
#pragma unroll
    for (int i = 0; i < 2; ++i)
#pragma unroll
      for (int j = 0; j < 2; ++j)
#pragma unroll
        for (int r = 0; r < 4; ++r)
          p.logits[(size_t)(m0 + wm * 32 + i * 16 + lq * 4 + r) * NE + wn * 32 + j * 16 + lr] = acc[i][j][r];
  }
}

__device__ void ph_rwkv_pre(const P& p, int l, int bid, int nb, char* smem) {
  float* lora = (float*)smem;
  const int tid = otid(), lane = tid & 63, w = tid >> 6;
  const float* mu = p.rwkv_mu + (size_t)l * NRWC;
  const float* w0 = p.rwkv_w0 + (size_t)l * RW; const float* w2 = p.rwkv_w2 + (size_t)l * 64 * RW;
  const float* a0 = p.rwkv_a0 + (size_t)l * RW; const float* a2 = p.rwkv_a2 + (size_t)l * 64 * RW;
  const float* g2 = p.rwkv_g2 + (size_t)l * 128 * RW;
  const float* k_k = p.rwkv_k_k + (size_t)l * RW; const float* k_a = p.rwkv_k_a + (size_t)l * RW;
  const float* r_k = p.rwkv_r_k + (size_t)l * RW;
  for (int t = bid; t < L; t += nb) {
    const bf16_t* cur = p.proj + (size_t)t * PINP;
    const bf16_t* prv = cur - PINP;
    auto mix = [&](int col) -> float {
      float cv = bf2f(cur[col]);
      float pv = (t > 0) ? bf2f(prv[col]) : 0.f;
      return cv + (pv - cv) * mu[col];
    };
    __syncthreads();
    {
      float v = mix(C_WL + tid);
      if (tid < 64) v = tanhf(v);
      else if (tid >= 128) v = sigmoidf_(v);
      lora[tid] = v;
    }
    __syncthreads();
    for (int hd = w; hd < 6; hd += 4) {
      const int c = hd * 64 + lane;
      float r = mix(C_R + c), k = mix(C_K + c), v = mix(C_V + c);
      float wacc = 0.f, aacc = 0.f, gacc = 0.f;
      for (int j = 0; j < 64; ++j) { wacc += lora[j] * w2[j * RW + c]; aacc += lora[64 + j] * a2[j * RW + c]; }
      for (int j = 0; j < 128; ++j) gacc += lora[128 + j] * g2[j * RW + c];
      wacc += w0[c]; aacc += a0[c];
      float wl = -softplusf_(-wacc) - 0.5f;
      float decay = expf(-expf(wl));
      float a = sigmoidf_(aacc);
      float kkv = k * k_k[c];
      float nrm = sqrtf(wave_sum(kkv * kkv));
      float kk = kkv / fmaxf(nrm, 1e-12f);
      float k2 = k * (1.f + (a - 1.f) * k_a[c]);
      float bon = wave_sum(r * k2 * r_k[c]);
      size_t o = (size_t)t * RW + c;
      p.rw_r[o] = r; p.rw_w[o] = decay; p.rw_k[o] = k2; p.rw_v[o] = v; p.rw_kk[o] = kk; p.rw_b[o] = kk * a; p.rw_g[o] = gacc;
      if (lane == 0) p.rw_bonus[(size_t)t * 6 + hd] = bon;
    }
  }
}

__device__ __forceinline__ float red16(float v) {
  v += __shfl_xor(v, 8); v += __shfl_xor(v, 4); v += __shfl_xor(v, 2); v += __shfl_xor(v, 1);
  return v;
}
struct ScanIn { f32x4 kk, w, b, k, r; float v; };
__device__ __forceinline__ ScanIn scan_load(const P& p, int t, int coff, int voff) {
  ScanIn s; size_t o = (size_t)t * RW;
  s.kk = *(const f32x4*)(p.rw_kk + o + coff); s.w = *(const f32x4*)(p.rw_w + o + coff); s.b = *(const f32x4*)(p.rw_b + o + coff);
  s.k = *(const f32x4*)(p.rw_k + o + coff); s.r = *(const f32x4*)(p.rw_r + o + coff); s.v = p.rw_v[o + voff];
  return s;
}
__device__ void ph_rwkv_scan(const P& p, int bid, int nb) {
  const int tid = otid(), lane = tid & 63, w = tid >> 6;
  for (int item = bid; item < 24; item += nb) {
    const int hd = item >> 2, vg = item & 3;
    const int vrow = vg * 16 + w * 4 + (lane >> 4), kg = lane & 15;
    const int coff = hd * 64 + kg * 4, voff = hd * 64 + vrow;
    f32x4 S = (f32x4){0, 0, 0, 0};
    ScanIn buf[4];
#pragma unroll
    for (int u = 0; u < 4; ++u) buf[u] = scan_load(p, u, coff, voff);
    for (int t0 = 0; t0 < L; t0 += 4) {
#pragma unroll
      for (int u = 0; u < 4; ++u) {
        ScanIn cu = buf[u];
        if (t0 + u + 4 < L) buf[u] = scan_load(p, t0 + u + 4, coff, voff);
        float pd = S.x * cu.kk.x + S.y * cu.kk.y + S.z * cu.kk.z + S.w * cu.kk.w;
        float sa = -red16(pd);
        S.x = S.x * cu.w.x + sa * cu.b.x + cu.v * cu.k.x;
        S.y = S.y * cu.w.y + sa * cu.b.y + cu.v * cu.k.y;
        S.z = S.z * cu.w.z + sa * cu.b.z + cu.v * cu.k.z;
        S.w = S.w * cu.w.w + sa * cu.b.w + cu.v * cu.k.w;
        float y = red16(S.x * cu.r.x + S.y * cu.r.y + S.z * cu.r.z + S.w * cu.r.w);
        if (kg == 0) p.rw_y[(size_t)(t0 + u) * RW + voff] = y;
      }
    }
  }
}

__device__ void ph_rwkv_post(const P& p, int l, int bid, int nb) {
  const int tid = otid(), lane = tid & 63, w = tid >> 6;
  const float* lg = p.rwkv_ln_g + (size_t)l * RW; const float* lb = p.rwkv_ln_b + (size_t)l * RW;
  for (int item = bid * 4 + w; item < L * 6; item += nb * 4) {
    const int t = item / 6, hd = item % 6, c = hd * 64 + lane;
    size_t o = (size_t)t * RW + c;
    float y = p.rw_y[o];
    float mean = wave_sum(y) * (1.f / 64.f);
    float d = y - mean;
    float var = wave_sum(d * d) * (1.f / 64.f);
    float on = d * rsqrtf(var + GN_EPS) * lg[c] + lb[c];
    float res = (on + p.rw_bonus[(size_t)t * 6 + hd] * p.rw_v[o]) * p.rw_g[o];
    p.mixed[(size_t)t * D + c] = f2bf(res);
  }
}

__device__ void ph_dsa_pre(const P& p, int l, int bid, int nb, char* smem) {
  float* q = (float*)smem;
  const int tid = otid(), lane = tid & 63, w = tid >> 6;
  const float* kvn = p.dsa_kv_norm + (size_t)l * KVL;
  const float* ikg = p.dsa_ik_g + (size_t)l * 64; const float* ikb = p.dsa_ik_b + (size_t)l * 64;
  const float* wuk = p.dsa_w_uk + (size_t)l * 4 * 64 * KVL;
  for (int t = bid; t < L; t += nb) {
    const bf16_t* cur = p.proj + (size_t)t * PINP;
    __syncthreads();
    q[tid] = bf2f(cur[C_DQ + tid]);
    if (w == 0) {
      float a = bf2f(cur[C_CKV + lane]), b = bf2f(cur[C_CKV + 64 + lane]);
      float ms = wave_sum(a * a + b * b) * (1.f / 128.f);
      float rs = rsqrtf(ms + 1e-6f);
      p.ckv[(size_t)t * KVL + lane] = a * rs * kvn[lane];
      p.ckv[(size_t)t * KVL + 64 + lane] = b * rs * kvn[64 + lane];
    } else if (w == 1) {
      float a = bf2f(cur[C_IK + lane]);
      float mean = wave_sum(a) * (1.f / 64.f);
      float d = a - mean;
      float var = wave_sum(d * d) * (1.f / 64.f);
      p.ikn[(size_t)t * 64 + lane] = f2bf(d * rsqrtf(var + LN_EPS) * ikg[lane] + ikb[lane]);
    } else if (w == 2) {
      if (lane < 4) p.iws[(size_t)t * 4 + lane] = bf2f(cur[C_IW + lane]) * (1.f / 16.f);
    }
    __syncthreads();
    for (int o = tid; o < 512; o += 256) {
      const int hd = o >> 7, r = o & 127;
      float s = 0.f;
      for (int d = 0; d < 64; ++d) s += q[hd * 64 + d] * wuk[(size_t)(hd * 64 + d) * KVL + r];
      p.qlat[(size_t)t * 512 + o] = s * 0.125f;
    }
  }
}

__device__ __forceinline__ size_t keys_rowoff(int t) {
  const int qt = t >> 7;
  return (size_t)qt * (qt + 1) / 2 * (128 * 128) + (size_t)(t & 127) * (qt + 1) * 128;
}
__device__ __forceinline__ unsigned okey16(float f) {
  unsigned u = __float_as_uint(f);
  u = (u & 0x80000000u) ? ~u : (u | 0x80000000u);
  return u >> 16;
}
__device__ void ph_idx_scores(const P& p, int bid, int nb, char* smem) {
  LDSP char* lds = (LDSP char*)smem;
  const int tid = otid(), lane = tid & 63, w = tid >> 6, wr = w >> 1, wc = w & 1;
  const int fr = lane & 15, fq = lane >> 4;
  const int srow = tid >> 3, c16 = (tid & 7) ^ (srow & 7);
  const int x7 = fr & 7;
  constexpr int NCH = (NQT + KCH - 1) / KCH;
  for (int unit = bid; unit < NQT * NCH; unit += nb) {
    const int qt = unit / NCH, ch = unit % NCH;
    if (ch * KCH > qt) continue;
    const int q0 = qt * 128;
    __syncthreads();
#pragma unroll
    for (int hd = 0; hd < 4; ++hd)
#pragma unroll
      for (int i = 0; i < 4; ++i)
        glds16(p.proj + (size_t)(q0 + i * 32 + srow) * PINP + C_IQ + hd * 64 + c16 * 8, lds + hd * 16384 + (i * 256 + tid) * 16);
    f32x4 wgt[4];
#pragma unroll
    for (int i = 0; i < 4; ++i) wgt[i] = *(const f32x4*)(p.iws + (size_t)(q0 + wr * 64 + i * 16 + fr) * 4);
    const int kt_end = min(qt + 1, (ch + 1) * KCH);
    for (int kt = ch * KCH; kt < kt_end; ++kt) {
      const int s0 = kt * 128;
      __syncthreads();
#pragma unroll
      for (int i = 0; i < 4; ++i) glds16(p.ikn + (size_t)(s0 + i * 32 + srow) * 64 + c16 * 8, lds + 65536 + (i * 256 + tid) * 16);
      asm volatile("s_waitcnt vmcnt(0)" ::: "memory");
      __syncthreads();
      f32x4 sc[4][4];
#pragma unroll
      for (int i = 0; i < 4; ++i)
#pragma unroll
        for (int j = 0; j < 4; ++j) sc[i][j] = (f32x4){0, 0, 0, 0};
#pragma unroll 1
      for (int hd = 0; hd < 4; ++hd) {
#pragma unroll
        for (int jh = 0; jh < 2; ++jh) {
          f32x4 acc[4][2];
#pragma unroll
          for (int i = 0; i < 4; ++i)
#pragma unroll
            for (int j = 0; j < 2; ++j) acc[i][j] = (f32x4){0, 0, 0, 0};
#pragma unroll
          for (int ks = 0; ks < 2; ++ks) {
            bf16x8 af[4], bfv[2];
            const int sw = ((ks * 4 + fq) ^ x7) << 4;
#pragma unroll
            for (int i = 0; i < 4; ++i) af[i] = *(LDSP const bf16x8*)(lds + hd * 16384 + (wr * 64 + i * 16 + fr) * 128 + sw);
#pragma unroll
            for (int j = 0; j < 2; ++j) bfv[j] = *(LDSP const bf16x8*)(lds + 65536 + (wc * 64 + (jh * 2 + j) * 16 + fr) * 128 + sw);
#pragma unroll
            for (int i = 0; i < 4; ++i)
#pragma unroll
              for (int j = 0; j < 2; ++j) acc[i][j] = __builtin_amdgcn_mfma_f32_16x16x32_bf16(bfv[j], af[i], acc[i][j], 0, 0, 0);
          }
#pragma unroll
          for (int i = 0; i < 4; ++i) {
            const float wg = (hd == 0) ? wgt[i][0] : (hd == 1) ? wgt[i][1] : (hd == 2) ? wgt[i][2] : wgt[i][3];
#pragma unroll
            for (int j = 0; j < 2; ++j) {
              sc[i][jh * 2 + j][0] += fmaxf(acc[i][j][0], 0.f) * wg; sc[i][jh * 2 + j][1] += fmaxf(acc[i][j][1], 0.f) * wg;
              sc[i][jh * 2 + j][2] += fmaxf(acc[i][j][2], 0.f) * wg; sc[i][jh * 2 + j][3] += fmaxf(acc[i][j][3], 0.f) * wg;
            }
          }
        }
      }
#pragma unroll
      for (int i = 0; i < 4; ++i) {
        const int q = q0 + wr * 64 + i * 16 + fr;
        bf16_t* kr = p.keys + keys_rowoff(q) + s0 + wc * 64 + fq * 4;
#pragma unroll
        for (int j = 0; j < 4; ++j) {
          uint2 pk;
          pk.x = okey16(sc[i][j][0]) | (okey16(sc[i][j][1]) << 16);
          pk.y = okey16(sc[i][j][2]) | (okey16(sc[i][j][3]) << 16);
          *(uint2*)(kr + j * 16) = pk;
        }
      }
    }
  }
}

__device__ void ph_topk(const P& p, int bid, int nb, char* smem) {
  bf16_t* keys = (bf16_t*)smem;
  unsigned* hist = (unsigned*)(smem + 32768);
  unsigned* misc = hist + 256;
  unsigned* tcnt = misc + 8;
  const int tid = otid();
  for (int t = bid; t < L; t += nb) {
    const int n = t + 1;
    int* out = p.idx + (size_t)t * TOPK;
    if (n <= TOPK) { out[tid] = (tid < n) ? tid : 0; continue; }
    __syncthreads();
    const bf16_t* krow = p.keys + keys_rowoff(t);
    const int n8 = (n + 7) >> 3;
    for (int i = tid; i < n8; i += 256) *(uint4*)(keys + i * 8) = *(const uint4*)(krow + i * 8);
    unsigned prefix = 0, mask = 0; int need = TOPK;
    for (int pass = 0; pass < 2; ++pass) {
      const int shift = 8 - 8 * pass;
      hist[tid] = 0;
      __syncthreads();
      for (int i = tid; i < n; i += 256) { unsigned k = keys[i]; if ((k & mask) == prefix) atomicAdd(&hist[(k >> shift) & 255u], 1u); }
      __syncthreads();
      if (tid == 0) {
        int cum = 0, dsel = 0;
        for (int b = 255; b >= 0; --b) { int hb = (int)hist[b]; if (cum + hb >= need) { dsel = b; break; } cum += hb; }
        misc[0] = (unsigned)dsel; misc[1] = (unsigned)(need - cum);
      }
      __syncthreads();
      prefix |= misc[0] << shift; mask |= 0xFFu << shift; need = (int)misc[1];
      __syncthreads();
    }
    const int ngt = TOPK - need;
    const int per = (n + 255) / 256;
    const int i0 = tid * per, i1 = min(n, i0 + per);
    int ceq = 0, cgt = 0;
    for (int i = i0; i < i1; ++i) { const unsigned k = keys[i]; ceq += (k == prefix); cgt += (k > prefix); }
    tcnt[tid] = (unsigned)ceq | ((unsigned)cgt << 16);
    __syncthreads();
    if (tid == 0) {
      unsigned re = 0, rg = 0;
      for (int i = 0; i < 256; ++i) { const unsigned c = tcnt[i]; tcnt[i] = re | (rg << 16); re += c & 0xffffu; rg += c >> 16; }
    }
    __syncthreads();
    int erank = (int)(tcnt[tid] & 0xffffu), grank = (int)(tcnt[tid] >> 16);
    for (int i = i0; i < i1; ++i) {
      const unsigned k = keys[i];
      if (k > prefix) { out[grank] = i; ++grank; }
      else if (k == prefix) { if (erank < need) out[ngt + erank] = i; ++erank; }
    }
  }
}

__device__ void ph_dsa_attn(const P& p, int l, int bid, int nb, char* smem) {
  float* ql = (float*)smem;
  int* sidx = (int*)(ql + 512);
  float* pr = (float*)(sidx + 256);
  float* ol = pr + 1024;
  const int tid = otid(), lane = tid & 63, w = tid >> 6;
  const float* wuv = p.dsa_w_uv + (size_t)l * 4 * KVL * 64;
  for (int t = bid; t < L; t += nb) {
    const int cnt = min(TOPK, t + 1);
    __syncthreads();
    ql[tid] = p.qlat[(size_t)t * 512 + tid]; ql[256 + tid] = p.qlat[(size_t)t * 512 + 256 + tid];
    const int id = (tid < cnt) ? p.idx[(size_t)t * TOPK + tid] : 0;
    sidx[tid] = id;
    __syncthreads();
    {
      float lg[4] = {0.f, 0.f, 0.f, 0.f};
      const float* crow = p.ckv + (size_t)id * KVL;
      for (int r = 0; r < KVL; r += 4) {
        f32x4 cv = *(const f32x4*)(crow + r);
#pragma unroll
        for (int hd = 0; hd < 4; ++hd)
          lg[hd] += ql[hd * 128 + r] * cv.x + ql[hd * 128 + r + 1] * cv.y + ql[hd * 128 + r + 2] * cv.z + ql[hd * 128 + r + 3] * cv.w;
      }
      const float dist = (float)(t - id);
#pragma unroll
      for (int hd = 0; hd < 4; ++hd) {
        const float slope = exp2f(-8.0f * (float)(6 + hd + 1) / 10.0f);
        pr[hd * 256 + tid] = (tid < cnt) ? (lg[hd] - slope * dist) : -INFINITY;
      }
    }
    __syncthreads();
    {
      float v[4]; float m = -INFINITY;
#pragma unroll
      for (int i = 0; i < 4; ++i) { v[i] = pr[w * 256 + lane + i * 64]; m = fmaxf(m, v[i]); }
      m = wave_max(m);
      float s = 0.f;
#pragma unroll
      for (int i = 0; i < 4; ++i) { v[i] = expf(v[i] - m); s += v[i]; }
      s = wave_sum(s);
      const float inv = 1.f / s;
#pragma unroll
      for (int i = 0; i < 4; ++i) pr[w * 256 + lane + i * 64] = v[i] * inv;
    }
    __syncthreads();
    {
      const int d = tid & 127, hp = tid >> 7;
      float a0 = 0.f, a1 = 0.f;
      for (int k = 0; k < cnt; ++k) {
        const float cv = p.ckv[(size_t)sidx[k] * KVL + d];
        a0 += pr[(hp * 2) * 256 + k] * cv; a1 += pr[(hp * 2 + 1) * 256 + k] * cv;
      }
      ol[(hp * 2) * 128 + d] = a0; ol[(hp * 2 + 1) * 128 + d] = a1;
    }
    __syncthreads();
    {
      const int hd = tid >> 6, e = tid & 63;
      float s = 0.f;
      for (int r = 0; r < KVL; ++r) s += ol[hd * 128 + r] * wuv[(size_t)(hd * KVL + r) * 64 + e];
      p.mixed[(size_t)t * D + RW + hd * 64 + e] = f2bf(s);
    }
  }
}

__device__ void ph_swa(const P& p, int l, int bid, int nb, char* smem) {
  const int tid = otid(), lane = tid & 63, w = tid >> 6;
  float* qs = (float*)smem + w * 64;
  const float* sinks = p.swa_sinks + (size_t)l * 6;
  for (int item = bid * 4 + w; item < L * 6; item += nb * 4) {
    const int t = item / 6, hq = item % 6, g = hq / 3;
    qs[lane] = bf2f(p.proj[(size_t)t * PINP + C_SQ + hq * 64 + lane]);
    const float slope = exp2f(-8.0f * (float)(hq + 1) / 10.0f);
    float lg[2];
#pragma unroll
    for (int i = 0; i < 2; ++i) {
      const int j = lane + i * 64;
      const int s = t - 127 + j;
      float v = -INFINITY;
      if (s >= 0) {
        const bf16_t* kr = p.proj + (size_t)s * PINP + C_SK + g * 64;
        float acc = 0.f;
        for (int d = 0; d < 64; d += 4) {
          uint2 kv = *(const uint2*)(kr + d);
          acc += qs[d] * __uint_as_float(kv.x << 16) + qs[d + 1] * __uint_as_float(kv.x & 0xffff0000u) +
                 qs[d + 2] * __uint_as_float(kv.y << 16) + qs[d + 3] * __uint_as_float(kv.y & 0xffff0000u);
        }
        v = acc * 0.125f - slope * (float)(t - s);
      }
      lg[i] = v;
    }
    const float sink = sinks[hq];
    const float m = fmaxf(wave_max(fmaxf(lg[0], lg[1])), sink);
    float e0 = expf(lg[0] - m), e1 = expf(lg[1] - m);
    const float den = wave_sum(e0 + e1) + expf(sink - m);
    e0 /= den; e1 /= den;
    float acc = 0.f;
    for (int j = 0; j < 128; ++j) {
      const int s = t - 127 + j;
      const float pj = __shfl((j < 64) ? e0 : e1, j & 63);
      if (s >= 0) acc += pj * bf2f(p.proj[(size_t)s * PINP + C_SV + g * 64 + lane]);
    }
    p.mixed[(size_t)t * D + RW + DSW + hq * 64 + lane] = f2bf(acc);
  }
}

template <bool COMBINE>
__device__ void ph_ln(const P& p, const float* xin, const float* gatev, const float* lng, const float* lnb,
                      float* xout, const float* nsh, const float* nsc, bf16_t* hout, float* hfout, int bid, int nb, char* smem) {
  float* red = (float*)smem;
  const int tid = otid(), lane = tid & 63, w = tid >> 6;
  const int c = tid * 4;
  for (int t = bid; t < L; t += nb) {
    f32x4 xv = *(const f32x4*)(xin + (size_t)t * D + c);
    f32x4 y;
    if (COMBINE) {
      f32x4 r = (f32x4){0, 0, 0, 0};
      for (int k = 0; k < TOPE + 1; ++k) {
        const int slot = (k < TOPE) ? p.pos[(size_t)t * TOPE + k] : (p.offs[NE] + t);
        uint2 ov = *(const uint2*)(p.osort + (size_t)slot * D + c);
        r.x += __uint_as_float(ov.x << 16); r.y += __uint_as_float(ov.x & 0xffff0000u);
        r.z += __uint_as_float(ov.y << 16); r.w += __uint_as_float(ov.y & 0xffff0000u);
      }
      y = r;
    } else {
      y = *(const f32x4*)(p.tmp + (size_t)t * D + c);
    }
    f32x4 gv = *(const f32x4*)(gatev + c);
    f32x4 v = xv * ALPHA + gv * y;
    float s = wave_sum(v.x + v.y + v.z + v.w);
    __syncthreads();
    if (lane == 0) red[w] = s;
    __syncthreads();
    const float mean = (red[0] + red[1] + red[2] + red[3]) * (1.f / D);
    f32x4 d = v - mean;
    float q = wave_sum(d.x * d.x + d.y * d.y + d.z * d.z + d.w * d.w);
    if (lane == 0) red[4 + w] = q;
    __syncthreads();
    const float var = (red[4] + red[5] + red[6] + red[7]) * (1.f / D);
    const float rs = rsqrtf(var + LN_EPS);
    f32x4 gg = *(const f32x4*)(lng + c), bb = *(const f32x4*)(lnb + c);
    f32x4 o = d * rs * gg + bb;
    *(f32x4*)(xout + (size_t)t * D + c) = o;
    if (hout) {
      f32x4 sc = *(const f32x4*)(nsc + c), sh = *(const f32x4*)(nsh + c);
      f32x4 hv = o * (sc + 1.f) + sh;
      uint2 pk; pk.x = pack2(hv.x, hv.y); pk.y = pack2(hv.z, hv.w);
      *(uint2*)(hout + (size_t)t * D + c) = pk;
      if (hfout) *(f32x4*)(hfout + (size_t)t * D + c) = hv;
    }
  }
}

__device__ void ph_route(const P& p, int l, int bid, int nb, char* smem) {
  const int tid = otid(), lane = tid & 63, w = tid >> 6;
  float* sel = (float*)smem + w * 128;
  float* gs = sel + 64;
  const float* bias = p.router_bias + (size_t)l * NE;
  int* cnt = p.cnt + l * NE;
  for (int i = bid * 256 + tid; i < CAPR; i += nb * 256) p.slot_tok[i] = L;
  for (int t = bid * 4 + w; t < L; t += nb * 4) {
    const float score = sigmoidf_(p.logits[(size_t)t * NE + lane]);
    const float sv = score + bias[lane];
    sel[lane] = sv;
    const int g = lane >> 3;
    int rg = 0;
#pragma unroll
    for (int j = 0; j < 8; ++j) { const int o = g * 8 + j; const float ov = sel[o]; rg += (ov > sv || (ov == sv && o < lane)) ? 1 : 0; }
    float contrib = (rg < 2) ? sv : 0.f;
    contrib += __shfl_xor(contrib, 1); contrib += __shfl_xor(contrib, 2); contrib += __shfl_xor(contrib, 4);
    if ((lane & 7) == 0) gs[g] = contrib;
    const float mygs = contrib;
    int grank = 0;
#pragma unroll
    for (int j = 0; j < 8; ++j) { const float ov = gs[j]; grank += (ov > mygs || (ov == mygs && j < g)) ? 1 : 0; }
    const float sv2 = (grank < 4) ? sv : -1e30f;
    sel[lane] = sv2;
    int rk = 0;
    for (int j = 0; j < 64; ++j) { const float ov = sel[j]; rk += (ov > sv2 || (ov == sv2 && j < lane)) ? 1 : 0; }
    const bool chosen = rk < TOPE;
    const float ssum = wave_sum(chosen ? score : 0.f);
    if (chosen) {
      const float gt = score / ssum * 2.5f;
      const int er = atomicAdd(&cnt[lane], 1);
      p.eidx[(size_t)t * TOPE + rk] = lane;
      p.gate[(size_t)t * TOPE + rk] = gt;
      p.erank[(size_t)t * TOPE + rk] = er;
    }
  }
}

__device__ void ph_moe_scatter(const P& p, int l, int bid, int nb, char* smem) {
  int* soffs = (int*)smem;
  __syncthreads();
  if (otid() == 0) {
    const int* cnt = p.cnt + l * NE;
    int off = 0, nt = 0;
    for (int e = 0; e < NE; ++e) {
      soffs[e] = off;
      const int tl = (cnt[e] + MT - 1) / MT;
      if (bid == 0) { p.offs[e] = off; for (int i = 0; i < tl; ++i) p.tile_e[nt + i] = e; }
      nt += tl; off += tl * MT;
    }
    soffs[NE] = off;
    if (bid == 0) {
      p.offs[NE] = off;
      for (int i = 0; i < L / MT; ++i) p.tile_e[nt + i] = NE;
      *p.ntm = nt + L / MT;
    }
  }
  __syncthreads();
  for (int i = bid * 256 + otid(); i < L * TOPE; i += nb * 256) {
    const int e = p.eidx[i];
    const int slot = soffs[e] + p.erank[i];
    p.slot_tok[slot] = i / TOPE;
    p.slot_gate[slot] = p.gate[i];
    p.pos[i] = slot;
  }
  const int so = soffs[NE];
  for (int i = bid * 256 + otid(); i < L; i += nb * 256) { p.slot_tok[so + i] = i; p.slot_gate[so + i] = 1.0f; }
}

__device__ __forceinline__ void gbar(unsigned* ctr, unsigned& epoch) {
  epoch += gridDim.x;
  asm volatile("s_waitcnt vmcnt(0)" ::: "memory");
  __syncthreads();
  if (otid() == 0) {
    __builtin_amdgcn_fence(__ATOMIC_RELEASE, "agent");
    asm volatile("s_waitcnt vmcnt(0)" ::: "memory");
    __hip_atomic_fetch_add(ctr, 1u, __ATOMIC_RELAXED, __HIP_MEMORY_SCOPE_AGENT);
    while (__hip_atomic_load(ctr, __ATOMIC_RELAXED, __HIP_MEMORY_SCOPE_AGENT) < epoch) __builtin_amdgcn_s_sleep(2);
    __builtin_amdgcn_fence(__ATOMIC_ACQUIRE, "agent");
    asm volatile("s_waitcnt vmcnt(0)" ::: "memory");
  }
  __syncthreads();
}

constexpr int SMEM_BYTES = 81920;
constexpr int NSCAN = 24;

__global__ void __launch_bounds__(256, 2) mega(P p, unsigned* bar) {
  __shared__ __attribute__((aligned(16))) char smem[SMEM_BYTES];
  cg::grid_group grid = cg::this_grid();
  const int bid = blockIdx.x, nb = gridDim.x;
  unsigned epoch = 0;
  ph_mod(p, bid, nb, smem);
  grid.sync();
  ph_hmod(p, p.x, p.mod + 0, p.mod + D, p.h, bid, nb);
  ph_convert(p, 0, bid, nb, smem);
  gbar(bar, epoch);
  for (int l = 0; l < DEPTH; ++l) {
    const float* mod = p.mod + (size_t)l * 6 * D;
    {
      BG g{}; g.A = p.h; g.lda = D; g.Bt = p.wb_in; g.K = D; g.C = p.proj; g.ldc = PINP; g.ntm = L / 128; g.ntn = PINP / 128;
      ph_bgemm<0>(g, bid, nb, smem);
    }
    gbar(bar, epoch);
    ph_rwkv_pre(p, l, bid, nb, smem);
    ph_dsa_pre(p, l, bid, nb, smem);
    gbar(bar, epoch);
    if (bid < NSCAN) ph_rwkv_scan(p, bid, NSCAN);
    else { ph_idx_scores(p, bid - NSCAN, nb - NSCAN, smem); ph_swa(p, l, bid - NSCAN, nb - NSCAN, smem); }
    gbar(bar, epoch);
    ph_topk(p, bid, nb, smem);
    ph_rwkv_post(p, l, bid, nb);
    gbar(bar, epoch);
    ph_dsa_attn(p, l, bid, nb, smem);
    gbar(bar, epoch);
    {
      BG g{}; g.A = p.mixed; g.lda = D; g.Bt = p.wb_out; g.K = D; g.C = p.tmp; g.ldc = D; g.ntm = L / 128; g.ntn = D / 128;
      ph_bgemm<1>(g, bid, nb, smem);
    }
    gbar(bar, epoch);
    {
      const float* xin = (l == 0) ? p.x : p.xb;
      ph_ln<false>(p, xin, mod + 2 * D, p.ln_mix_g + (size_t)l * D, p.ln_mix_b + (size_t)l * D, p.xa, mod + 3 * D, mod + 4 * D, p.h, p.hf, bid, nb, smem);
    }
    gbar(bar, epoch);
    ph_router_gemm(p, l, bid, nb, smem);
    gbar(bar, epoch);
    ph_route(p, l, bid, nb, smem);
    gbar(bar, epoch);
    ph_moe_scatter(p, l, bid, nb, smem);
    gbar(bar, epoch);
    {
      BG g{}; g.A = p.h; g.lda = D; g.rowidx = p.slot_tok; g.Bt = p.wb_up; g.bstride = (long)512 * D; g.tile_e = p.tile_e; g.K = D;
      g.C = p.hid; g.ldc = DE; g.ntm_ptr = p.ntm; g.ntn = 4;
      ph_bgemm<2>(g, bid, nb, smem);
    }
    gbar(bar, epoch);
    {
      BG g{}; g.A = p.hid; g.lda = DE; g.Bt = p.wb_dn; g.bstride = (long)D * DE; g.tile_e = p.tile_e; g.K = DE;
      g.C = p.osort; g.ldc = D; g.rowscale = p.slot_gate; g.ntm_ptr = p.ntm; g.ntn = D / 128;
      ph_bgemm<3>(g, bid, nb, smem);
    }
    gbar(bar, epoch);
    {
      const bool last = (l == DEPTH - 1);
      const float* nmod = mod + 6 * D;
      ph_ln<true>(p, p.xa, mod + 5 * D, p.ln_ffn_g + (size_t)l * D, p.ln_ffn_b + (size_t)l * D, last ? p.out : p.xb,
                  nmod + 0, nmod + D, last ? nullptr : p.h, nullptr, bid, nb, smem);
      if (!last) ph_convert(p, l + 1, bid, nb, smem);
    }
    if (l + 1 < DEPTH) gbar(bar, epoch);
  }
}

static inline char* carve(char*& cur, size_t bytes) { char* r = cur; cur += (bytes + 255) & ~(size_t)255; return r; }

extern "C" void kernel_launch(void* const* d_in, const int* in_sizes, int n_in,
                              void* d_out, int out_size, void* d_ws, size_t ws_size,
                              hipStream_t stream) {
  P p{};
  const float** ins = (const float**)&p.x;
  for (int i = 0; i < 35; ++i) ins[i] = (const float*)d_in[i];
  p.out = (float*)d_out;
  char* cur = (char*)d_ws;
  p.cnt = (int*)carve(cur, DEPTH * NE * 4);
  p.offs = (int*)carve(cur, (NE + 1) * 4);
  p.ntm = (int*)carve(cur, 4);
  p.tile_e = (int*)carve(cur, MAXTILES * 4);
  p.mod = (float*)carve(cur, (size_t)(DEPTH + 1) * 6 * D * 4);
  p.wb_in = (bf16_t*)carve(cur, (size_t)PINP * D * 2);
  p.wb_out = (bf16_t*)carve(cur, (size_t)D * D * 2);
  p.wb_up = (bf16_t*)carve(cur, (size_t)NEX * 512 * D * 2);
  p.wb_dn = (bf16_t*)carve(cur, (size_t)NEX * D * DE * 2);
  p.h = (bf16_t*)carve(cur, (size_t)(L + 1) * D * 2);
  p.hf = (float*)carve(cur, (size_t)L * D * 4);
  p.mixed = (bf16_t*)carve(cur, (size_t)L * D * 2);
  p.xa = (float*)carve(cur, (size_t)L * D * 4);
  p.xb = (float*)carve(cur, (size_t)L * D * 4);
  p.logits = (float*)carve(cur, (size_t)L * NE * 4);
  p.gate = (float*)carve(cur, (size_t)L * TOPE * 4);
  p.eidx = (int*)carve(cur, (size_t)L * TOPE * 4);
  p.erank = (int*)carve(cur, (size_t)L * TOPE * 4);
  p.pos = (int*)carve(cur, (size_t)L * TOPE * 4);
  p.slot_tok = (int*)carve(cur, (size_t)CAP * 4);
  p.slot_gate = (float*)carve(cur, (size_t)CAP * 4);
  char* ov = cur;
  p.proj = (bf16_t*)carve(cur, (size_t)L * PINP * 2);
  p.tmp = (float*)p.proj;
  p.rw_r = (float*)carve(cur, (size_t)L * RW * 4);
  p.rw_w = (float*)carve(cur, (size_t)L * RW * 4);
  p.rw_k = (float*)carve(cur, (size_t)L * RW * 4);
  p.rw_v = (float*)carve(cur, (size_t)L * RW * 4);
  p.rw_kk = (float*)carve(cur, (size_t)L * RW * 4);
  p.rw_b = (float*)carve(cur, (size_t)L * RW * 4);
  p.rw_g = (float*)carve(cur, (size_t)L * RW * 4);
  p.rw_y = (float*)carve(cur, (size_t)L * RW * 4);
  p.rw_bonus = (float*)carve(cur, (size_t)L * 6 * 4);
  p.ckv = (float*)carve(cur, (size_t)L * KVL * 4);
  p.qlat = (float*)carve(cur, (size_t)L * 512 * 4);
  p.ikn = (bf16_t*)carve(cur, (size_t)L * 64 * 2);
  p.iws = (float*)carve(cur, (size_t)L * 4 * 4);
  p.idx = (int*)carve(cur, (size_t)L * TOPK * 4);
  p.keys = (bf16_t*)carve(cur, (size_t)NQT * (NQT + 1) / 2 * 128 * 128 * 2);
  char* ovend = cur;
  char* cur2 = ov;
  p.hid = (bf16_t*)carve(cur2, (size_t)CAP * DE * 2);
  p.osort = (bf16_t*)carve(cur2, (size_t)CAP * D * 2);
  if (cur2 > ovend) ovend = cur2;
  if ((size_t)(ovend - (char*)d_ws) > ws_size) { fprintf(stderr, "workspace too small: need %zu have %zu\n", (size_t)(ovend - (char*)d_ws), ws_size); return; }

  unsigned* bar = (unsigned*)carve(cur, 256);
  if ((size_t)(cur - (char*)d_ws) > ws_size) { fprintf(stderr, "workspace too small\n"); return; }
  hipMemsetAsync(p.cnt, 0, DEPTH * NE * 4, stream);
  hipMemsetAsync(bar, 0, 256, stream);
  static int grid_blocks = 0;
  if (!grid_blocks) {
    int dev = 0, cus = 0, per_cu = 0;
    (void)hipGetDevice(&dev);
    (void)hipDeviceGetAttribute(&cus, hipDeviceAttributeMultiprocessorCount, dev);
    (void)hipOccupancyMaxActiveBlocksPerMultiprocessor(&per_cu, mega, 256, 0);
    if (per_cu > 2) per_cu = 2;
    if (per_cu < 1) per_cu = 1;
    grid_blocks = cus * per_cu;
  }
  void* args[] = {&p, &bar};
  hipError_t e = hipLaunchCooperativeKernel((void*)mega, dim3(grid_blocks), dim3(256), args, 0, stream);
  if (e != hipSuccess) fprintf(stderr, "cooperative launch failed: %s (grid %d)\n", hipGetErrorString(e), grid_blocks);
}
```

```cpp
#include <hip/hip_runtime.h>
#include <hip/hip_cooperative_groups.h>
#include <cstdio>
#include <cstdint>
namespace cg = cooperative_groups;

constexpr int L = 16384, D = 1024, DEPTH = 4;
constexpr int RW = 384, DSW = 256, SWW = 384;
constexpr int NRWC = 1408, PIN = 2756, PINP = 2816;
constexpr int C_R = 0, C_K = 384, C_V = 768, C_WL = 1152, C_AL = 1216, C_GL = 1280;
constexpr int C_DQ = 1408, C_CKV = 1664, C_IQ = 1792, C_IK = 2048, C_IW = 2112;
constexpr int C_SQ = 2120, C_SK = 2504, C_SV = 2632;
constexpr int KVL = 128, TOPK = 256;
constexpr int NE = 64, NEX = 65, TOPE = 8, DE = 256;
constexpr int MT = 128;
constexpr int CAPR = L * TOPE + NE * MT;
constexpr int CAP = CAPR + L;
constexpr int MAXTILES = CAP / MT;
constexpr float ALPHA = 1.681792830507429f;
constexpr float LN_EPS = 1e-5f, GN_EPS = 64e-5f;
constexpr int NQT = L / 128;
constexpr int KCH = 8;
constexpr int MXW = 1280;
constexpr int MX_DSA = 384, MX_SWA = 896;

typedef float f32x4 __attribute__((ext_vector_type(4)));
typedef short bf16x8 __attribute__((ext_vector_type(8)));
typedef unsigned short bf16_t;
typedef unsigned u32x4 __attribute__((ext_vector_type(4)));
typedef unsigned u32x2 __attribute__((ext_vector_type(2)));
typedef __bf16 bf16x2_t __attribute__((ext_vector_type(2)));
#define LDSP __attribute__((address_space(3)))

struct P {
  const float *x, *c, *w_mod, *b_mod, *w_in, *rwkv_mu, *rwkv_w0, *rwkv_w2, *rwkv_a0, *rwkv_a2, *rwkv_g2;
  const float *rwkv_k_k, *rwkv_k_a, *rwkv_r_k, *rwkv_ln_g, *rwkv_ln_b, *dsa_kv_norm, *dsa_w_uk, *dsa_w_uv;
  const float *dsa_ik_g, *dsa_ik_b, *swa_sinks, *w_out, *ln_mix_g, *ln_mix_b, *router_w, *router_bias;
  const float *exp_w1, *exp_w3, *exp_w2, *sh_w1, *sh_w3, *sh_w2, *ln_ffn_g, *ln_ffn_b;
  float* out;
  float *rw5, *mod, *hf, *rw_r, *rw_w, *rw_k, *rw_v, *rw_kk, *rw_b, *rw_g, *rw_bonus, *rw_y;
  float *ckv, *qlat, *iws, *tmp, *xa, *xb, *logits, *gate, *slot_gate;
  int *idx, *eidx, *erank, *pos, *cnt, *offs, *tile_e, *ntm, *slot_tok;
  float* lacc;
  bf16_t *cMT, *cRP, *cNT, *cY1;
  bf16_t *loraA, *wb_w2, *wb_a2, *wb_g2, *wb_uk;
  bf16_t *ckvb, *h, *proj, *mixed, *ikn, *hid, *osort, *keys, *wb_in, *wb_out, *wb_up, *wb_dn;
};

__device__ __forceinline__ int otid() { int t = (int)__builtin_amdgcn_workitem_id_x(); asm volatile("" : "+v"(t)); return t; }
__device__ __forceinline__ float wave_sum(float v) {
#pragma unroll
  for (int o = 32; o > 0; o >>= 1) v += __shfl_xor(v, o);
  return v;
}
__device__ __forceinline__ float wave_max(float v) {
#pragma unroll
  for (int o = 32; o > 0; o >>= 1) v = fmaxf(v, __shfl_xor(v, o));
  return v;
}
__device__ __forceinline__ float sigmoidf_(float x) { return 1.0f / (1.0f + expf(-x)); }
__device__ __forceinline__ float siluf_(float x) { return x / (1.0f + expf(-x)); }
__device__ __forceinline__ float softplusf_(float x) { return fmaxf(x, 0.f) + log1pf(expf(-fabsf(x))); }
__device__ __forceinline__ bf16_t f2bf(float f) {
  unsigned u = __float_as_uint(f);
  u += 0x7fffu + ((u >> 16) & 1u);
  return (bf16_t)(u >> 16);
}
__device__ __forceinline__ float bf2f(bf16_t h) { return __uint_as_float(((unsigned)h) << 16); }
typedef float f32x2_t __attribute__((ext_vector_type(2)));
__device__ __forceinline__ unsigned pack2(float a, float b) { f32x2_t v = {a, b}; return __builtin_bit_cast(unsigned, __builtin_convertvector(v, bf16x2_t)); }

__device__ void ph_mod(const P& p, int bid, int nb, char* smem) {
  float* cond = (float*)smem;
  for (int i = otid(); i < D; i += 256) cond[i] = siluf_(p.c[i]);
  __syncthreads();
  for (int i = bid * 256 + otid(); i < DEPTH * 6 * D; i += nb * 256) {
    int l = i / (6 * D), j = i % (6 * D);
    const float* w = p.w_mod + (size_t)l * D * 6 * D + j;
    float s = 0.f;
    for (int k = 0; k < D; ++k) s += cond[k] * w[(size_t)k * 6 * D];
    p.mod[i] = s + p.b_mod[i];
  }
}

__device__ void ph_hmod(const P& p, const float* x, const float* sh, const float* sc, bf16_t* h, int bid, int nb) {
  for (size_t i = (size_t)bid * 256 + otid(); i < (size_t)L * D / 4; i += (size_t)nb * 256) {
    int c4 = (int)(i % (D / 4)) * 4;
    f32x4 v = *(const f32x4*)(x + i * 4);
    f32x4 s = *(const f32x4*)(sc + c4), b = *(const f32x4*)(sh + c4);
    f32x4 o = v * (s + 1.f) + b;
    uint2 pk; pk.x = pack2(o.x, o.y); pk.y = pack2(o.z, o.w);
    *(uint2*)(h + i * 4) = pk;
  }
  for (int i = bid * 256 + otid(); i < D; i += nb * 256) h[(size_t)L * D + i] = 0;
}

__device__ void conv_tile(bf16_t* dst, int K, const float* src0, const float* src1, int ld, int mode, int nvalid, int nt, int kt, float (*t)[65], float scale = 1.0f) {
  const int tid = otid();
  const int n0 = nt * 64, k0 = kt * 64;
  __syncthreads();
  for (int i = tid; i < 4096; i += 256) {
    const int kk = i >> 6, nn = i & 63;
    float v = 0.f;
    if (mode == 0) { const int col = n0 + nn; if (col < nvalid) v = src0[(size_t)(k0 + kk) * ld + col]; }
    else if (mode == 3) { const int n = n0 + nn, col = (n < 2116) ? n : (n - 4); if ((n < 2116 || n >= 2120) && col < nvalid) v = src0[(size_t)(k0 + kk) * ld + col]; }
    else { const int col = (n0 >> 6) * 32 + (nn & 31); v = ((nn < 32) ? src0 : src1)[(size_t)(k0 + kk) * ld + col]; }
    t[kk][nn] = v;
  }
  __syncthreads();
  for (int i = tid; i < 2048; i += 256) {
    const int nn = i >> 5, k2 = (i & 31) * 2;
    *(unsigned*)(dst + (size_t)(n0 + nn) * K + k0 + k2) = pack2(t[k2][nn] * scale, t[k2 + 1][nn] * scale);
  }
}
__device__ void conv_out_tile(const P& p, int l, int nt, int kt, float (*t)[65]) {
  const int tid = otid();
  const int n0 = nt * 64, k0 = kt * 64;
  const float* wo = p.w_out + (size_t)l * D * D;
  __syncthreads();
  if (k0 < MX_DSA || k0 >= MX_SWA) {
    const int kr = (k0 < MX_DSA) ? k0 : (k0 - MX_SWA + 640);
    for (int i = tid; i < 4096; i += 256) { const int kk = i >> 6, nn = i & 63; t[kk][nn] = wo[(size_t)(kr + kk) * D + n0 + nn]; }
  } else {
    const int hd = (k0 - MX_DSA) / KVL, r0 = (k0 - MX_DSA) % KVL;
    const float* wuv = p.dsa_w_uv + ((size_t)l * 4 + hd) * KVL * 64;
    for (int i = tid; i < 4096; i += 256) {
      const int kk = i >> 6, nn = i & 63;
      float acc = 0.f;
      for (int e = 0; e < 64; ++e) acc += wuv[(size_t)(r0 + kk) * 64 + e] * wo[(size_t)(384 + hd * 64 + e) * D + n0 + nn];
      t[kk][nn] = acc;
    }
  }
  __syncthreads();
  for (int i = tid; i < 2048; i += 256) {
    const int nn = i >> 5, k2 = (i & 31) * 2;
    *(unsigned*)(p.wb_out + (size_t)(n0 + nn) * MXW + k0 + k2) = pack2(t[k2][nn], t[k2 + 1][nn]);
  }
}
__device__ void ph_convert(const P& p, int l, int bid, int nb, char* smem) {
  float (*t)[65] = (float (*)[65])smem;
  constexpr int T_IN = (PINP / 64) * (D / 64), T_OUT = (D / 64) * (MXW / 64), T_UP = (512 / 64) * (D / 64), T_DN = (D / 64) * (DE / 64);
  constexpr int T_SM = 6 + 6 + 12 + 8;
  constexpr int TOT = T_IN + T_OUT + NEX * T_UP + NEX * T_DN + T_SM;
  for (int job = bid; job < TOT; job += nb) {
    int j = job;
    if (j < T_IN) { conv_tile(p.wb_in, D, p.w_in + (size_t)l * D * PIN, nullptr, PIN, 3, PIN, j / (D / 64), j % (D / 64), t); continue; }
    j -= T_IN;
    if (j < T_OUT) { conv_out_tile(p, l, j / (MXW / 64), j % (MXW / 64), t); continue; }
    j -= T_OUT;
    if (j < NEX * T_UP) {
      const int e = j / T_UP, r = j % T_UP;
      const float* s1 = (e < NE) ? p.exp_w1 + ((size_t)l * NE + e) * D * DE : p.sh_w1 + (size_t)l * D * DE;
      const float* s3 = (e < NE) ? p.exp_w3 + ((size_t)l * NE + e) * D * DE : p.sh_w3 + (size_t)l * D * DE;
      conv_tile(p.wb_up + (size_t)e * 512 * D, D, s1, s3, DE, 1, 0, r / (D / 64), r % (D / 64), t);
      continue;
    }
    j -= NEX * T_UP;
    if (j >= NEX * T_DN) {
      j -= NEX * T_DN;
      if (j < 6) conv_tile(p.wb_w2, 64, p.rwkv_w2 + (size_t)l * 64 * RW, nullptr, RW, 0, RW, j, 0, t);
      else if (j < 12) conv_tile(p.wb_a2, 64, p.rwkv_a2 + (size_t)l * 64 * RW, nullptr, RW, 0, RW, j - 6, 0, t);
      else if (j < 24) conv_tile(p.wb_g2, 128, p.rwkv_g2 + (size_t)l * 128 * RW, nullptr, RW, 0, RW, (j - 12) >> 1, (j - 12) & 1, t);
      else { const int hd = (j - 24) >> 1, nt = (j - 24) & 1; conv_tile(p.wb_uk + (size_t)hd * KVL * 64, 64, p.dsa_w_uk + ((size_t)l * 4 + hd) * 64 * KVL, nullptr, KVL, 0, KVL, nt, 0, t, 0.125f); }
      continue;
    }
    {
      const int e = j / T_DN, r = j % T_DN;
      const float* s2 = (e < NE) ? p.exp_w2 + ((size_t)l * NE + e) * DE * D : p.sh_w2 + (size_t)l * DE * D;
      conv_tile(p.wb_dn + (size_t)e * D * DE, DE, s2, nullptr, D, 0, D, r / (DE / 64), r % (DE / 64), t);
    }
  }
}

struct BG {
  const bf16_t* A; const int* rowidx; const bf16_t* Bt; const int* tile_e; const int* ntm_ptr;
  void* C; const float* rowscale;
  long bstride; int lda, K, ldc, ntm, ntn, pad;
};
__device__ __forceinline__ void glds16(const void* g, LDSP void* l) {
  __builtin_amdgcn_global_load_lds((const unsigned*)g, (LDSP unsigned*)l, 16, 0, 0);
}
template <int EPI>
__device__ void ph_bgemm(const BG& g, int bid, int nb, char* smem) {
  LDSP char* lds = (LDSP char*)smem;
  const int tid = otid(), lane = tid & 63, w = tid >> 6, wr = w >> 1, wc = w & 1;
  const int fr = lane & 15, fq = lane >> 4;
  const int ntm = g.ntm_ptr ? *g.ntm_ptr : g.ntm;
  const int ntn = g.ntn, nk = g.K / 64;
  const int srow = tid >> 3, c16 = (tid & 7) ^ (srow & 7);
  const int x7 = fr & 7;
  for (int tile = bid; tile < ntm * ntn; tile += nb) {
    const int mt = tile / ntn, nt = tile % ntn;
    const int m0 = mt * 128, n0 = nt * 128;
    const bf16_t* Bt = g.Bt;
    if (g.tile_e) Bt += (long)g.tile_e[mt] * g.bstride;
    const bf16_t* ap[4]; const bf16_t* bp[4];
#pragma unroll
    for (int i = 0; i < 4; ++i) {
      int ar = m0 + i * 32 + srow;
      if (g.rowidx) ar = g.rowidx[ar];
      ap[i] = g.A + (size_t)ar * g.lda + c16 * 8;
      bp[i] = Bt + (size_t)(n0 + i * 32 + srow) * g.K + c16 * 8;
    }
    f32x4 acc[4][4];
#pragma unroll
    for (int i = 0; i < 4; ++i)
#pragma unroll
      for (int j = 0; j < 4; ++j) acc[i][j] = (f32x4){0, 0, 0, 0};
#pragma unroll
    for (int i = 0; i < 4; ++i) {
      glds16(ap[i], lds + (i * 256 + tid) * 16);
      glds16(bp[i], lds + 16384 + (i * 256 + tid) * 16);
    }
    asm volatile("s_waitcnt vmcnt(0)" ::: "memory");
    __syncthreads();
    for (int kt = 0; kt < nk; ++kt) {
      const int cur = kt & 1;
      if (kt + 1 < nk) {
        LDSP char* nb_ = lds + (cur ^ 1) * 32768;
#pragma unroll
        for (int i = 0; i < 4; ++i) {
          glds16(ap[i] + (kt + 1) * 64, nb_ + (i * 256 + tid) * 16);
          glds16(bp[i] + (kt + 1) * 64, nb_ + 16384 + (i * 256 + tid) * 16);
        }
      }
      LDSP char* la = lds + cur * 32768;
      LDSP char* lb = la + 16384;
#pragma unroll
      for (int ks = 0; ks < 2; ++ks) {
        bf16x8 af[4], bfv[4];
        const int sw = ((ks * 4 + fq) ^ x7) << 4;
#pragma unroll
        for (int i = 0; i < 4; ++i) {
          af[i] = *(LDSP const bf16x8*)(la + (wr * 64 + i * 16 + fr) * 128 + sw);
          bfv[i] = *(LDSP const bf16x8*)(lb + (wc * 64 + i * 16 + fr) * 128 + sw);
        }
#pragma unroll
        for (int i = 0; i < 4; ++i)
#pragma unroll
          for (int j = 0; j < 4; ++j) acc[i][j] = __builtin_amdgcn_mfma_f32_16x16x32_bf16(bfv[j], af[i], acc[i][j], 0, 0, 0);
      }
      asm volatile("s_waitcnt vmcnt(0)" ::: "memory");
      __syncthreads();
    }
#pragma unroll
    for (int i = 0; i < 4; ++i) {
      const int row = m0 + wr * 64 + i * 16 + fr;
      if (EPI == 0) {
        bf16_t* C = (bf16_t*)g.C;
#pragma unroll
        for (int j = 0; j < 4; ++j) {
          uint2 pk; pk.x = pack2(acc[i][j][0], acc[i][j][1]); pk.y = pack2(acc[i][j][2], acc[i][j][3]);
          *(uint2*)(C + (size_t)row * g.ldc + n0 + wc * 64 + j * 16 + fq * 4) = pk;
        }
      } else if (EPI == 1) {
        float* C = (float*)g.C;
#pragma unroll
        for (int j = 0; j < 4; ++j) *(f32x4*)(C + (size_t)row * g.ldc + n0 + wc * 64 + j * 16 + fq * 4) = acc[i][j];
      } else if (EPI == 2) {
        bf16_t* C = (bf16_t*)g.C;
#pragma unroll
        for (int j = 0; j < 2; ++j) {
          f32x4 a = acc[i][j], b = acc[i][j + 2];
          uint2 pk; pk.x = pack2(siluf_(a[0]) * b[0], siluf_(a[1]) * b[1]); pk.y = pack2(siluf_(a[2]) * b[2], siluf_(a[3]) * b[3]);
          *(uint2*)(C + (size_t)row * g.ldc + nt * 64 + wc * 32 + j * 16 + fq * 4) = pk;
        }
      } else {
        bf16_t* C = (bf16_t*)g.C;
        const float sc = g.rowscale[row];
#pragma unroll
        for (int j = 0; j < 4; ++j) {
          uint2 pk; pk.x = pack2(acc[i][j][0] * sc, acc[i][j][1] * sc); pk.y = pack2(acc[i][j][2] * sc, acc[i][j][3] * sc);
          *(uint2*)(C + (size_t)row * g.ldc + n0 + wc * 64 + j * 16 + fq * 4) = pk;
        }
      }
    }
  }
}

__device__ void ph_router_gemm(const P& p, int l, int bid, int nb, char* smem) {
  float (*As)[80] = (float (*)[80])smem;
  float (*Bs)[80] = (float (*)[80])(smem + 16 * 80 * 4);
  const int tid = otid(), lane = tid & 63, w = tid >> 6, wm = w >> 1, wn = w & 1;
  const int lr = lane & 15, lq = lane >> 4;
  const float* B = p.router_w + (size_t)l * D * NE;
  for (int mt = bid; mt < L / 64; mt += nb) {
    const int m0 = mt * 64;
    f32x4 acc[2][2];
#pragma unroll
    for (int i = 0; i < 2; ++i)
#pragma unroll
      for (int j = 0; j < 2; ++j) acc[i][j] = (f32x4){0, 0, 0, 0};
    const int arow_l = tid >> 2, akq = (tid & 3) * 4;
    const int bk = tid >> 4, bn4 = (tid & 15) * 4;
    for (int k0 = 0; k0 < D; k0 += 16) {
      f32x4 av = *(const f32x4*)(p.hf + (size_t)(m0 + arow_l) * D + k0 + akq);
      f32x4 bv = *(const f32x4*)(B + (size_t)(k0 + bk) * NE + bn4);
      __syncthreads();
      As[akq + 0][arow_l] = av.x; As[akq + 1][arow_l] = av.y; As[akq + 2][arow_l] = av.z; As[akq + 3][arow_l] = av.w;
      *(f32x4*)&Bs[bk][bn4] = bv;
      __syncthreads();
#pragma unroll
      for (int kk = 0; kk < 4; ++kk) {
        float a[2], b[2];
#pragma unroll
        for (int i = 0; i < 2; ++i) a[i] = As[kk * 4 + lq][wm * 32 + i * 16 + lr];
#pragma unroll
        for (int j = 0; j < 2; ++j) b[j] = Bs[kk * 4 + lq][wn * 32 + j * 16 + lr];
#pragma unroll
        for (int i = 0; i < 2; ++i)
#pragma unroll
          for (int j = 0; j < 2; ++j) acc[i][j] = __builtin_amdgcn_mfma_f32_16x16x4f32(a[i], b[j], acc[i][j], 0, 0, 0);
      }
    }
#pragma unroll
    for (int i = 0; i < 2; ++i)
#pragma unroll
      for (int j = 0; j < 2; ++j)
#pragma unroll
        for (int r = 0; r < 4; ++r)
          p.logits[(size_t)(m0 + wm * 32 + i * 16 + lq * 4 + r) * NE + wn * 32 + j * 16 + lr] = acc[i][j][r];
  }
}

__device__ __forceinline__ float tshift(const bf16_t* cur, int t, int col, const float* mu) {
  const float cv = bf2f(cur[col]);
  const float pv = (t > 0) ? bf2f(cur[col - PINP]) : 0.f;
  return cv + (pv - cv) * mu[col];
}
__device__ void ph_pre1(const P& p, int l, int bid, int nb) {
  const int tid = otid(), lane = tid & 63, w = tid >> 6;
  const float* mu = p.rwkv_mu + (size_t)l * NRWC;
  const float* kvn = p.dsa_kv_norm + (size_t)l * KVL;
  const float* ikg = p.dsa_ik_g + (size_t)l * 64; const float* ikb = p.dsa_ik_b + (size_t)l * 64;
  for (int t = bid * 4 + w; t < L; t += nb * 4) {
    const bf16_t* cur = p.proj + (size_t)t * PINP;
    bf16_t* lo = p.loraA + (size_t)t * 256;
    lo[lane] = f2bf(tanhf(tshift(cur, t, C_WL + lane, mu)));
    lo[64 + lane] = f2bf(tshift(cur, t, C_AL + lane, mu));
    lo[128 + lane] = f2bf(sigmoidf_(tshift(cur, t, C_GL + lane, mu)));
    lo[192 + lane] = f2bf(sigmoidf_(tshift(cur, t, C_GL + 64 + lane, mu)));
    {
      const float a = bf2f(cur[C_CKV + lane]), b = bf2f(cur[C_CKV + 64 + lane]);
      const float ms = wave_sum(a * a + b * b) * (1.f / 128.f);
      const float rs = rsqrtf(ms + 1e-6f);
      p.ckvb[(size_t)t * KVL + lane] = f2bf(a * rs * kvn[lane]);
      p.ckvb[(size_t)t * KVL + 64 + lane] = f2bf(b * rs * kvn[64 + lane]);
    }
    {
      const float a = bf2f(cur[C_IK + lane]);
      const float mean = wave_sum(a) * (1.f / 64.f);
      const float d = a - mean;
      const float var = wave_sum(d * d) * (1.f / 64.f);
      p.ikn[(size_t)t * 64 + lane] = f2bf(d * rsqrtf(var + LN_EPS) * ikg[lane] + ikb[lane]);
    }
    if (lane < 4) p.iws[(size_t)t * 4 + lane] = bf2f(cur[C_IW + lane]) * (1.f / 16.f);
  }
}

__device__ void ph_pre3(const P& p, int l, int bid, int nb) {
  const int tid = otid(), lane = tid & 63, w = tid >> 6;
  const float* mu = p.rwkv_mu + (size_t)l * NRWC;
  const float* w0 = p.rwkv_w0 + (size_t)l * RW; const float* a0 = p.rwkv_a0 + (size_t)l * RW;
  const float* k_k = p.rwkv_k_k + (size_t)l * RW; const float* k_a = p.rwkv_k_a + (size_t)l * RW;
  const float* r_k = p.rwkv_r_k + (size_t)l * RW;
  for (int item = bid * 4 + w; item < L * 6; item += nb * 4) {
    const int t = item / 6, hd = item % 6, c = hd * 64 + lane;
    const bf16_t* cur = p.proj + (size_t)t * PINP;
    const float r = tshift(cur, t, C_R + c, mu), k = tshift(cur, t, C_K + c, mu), v = tshift(cur, t, C_V + c, mu);
    const float* la = p.lacc + (size_t)t * (3 * RW);
    const float wacc = la[c] + w0[c], aacc = la[RW + c] + a0[c], gacc = la[2 * RW + c];
    const float wl = -softplusf_(-wacc) - 0.5f;
    const float decay = expf(-expf(wl));
    const float a = sigmoidf_(aacc);
    const float kkv = k * k_k[c];
    const float nrm = sqrtf(wave_sum(kkv * kkv));
    const float kk = kkv / fmaxf(nrm, 1e-12f);
    const float k2 = k * (1.f + (a - 1.f) * k_a[c]);
    const float bon = wave_sum(r * k2 * r_k[c]);
    const size_t o = (size_t)t * RW + c;
    p.rw_r[o] = r; p.rw_w[o] = decay; p.rw_k[o] = k2; p.rw_v[o] = v; p.rw_kk[o] = kk; p.rw_b[o] = kk * a; p.rw_g[o] = gacc;
    if (lane == 0) p.rw_bonus[(size_t)t * 6 + hd] = bon;
  }
}

template <int CTRL> __device__ __forceinline__ float dpp_mov(float x) {
  return __int_as_float(__builtin_amdgcn_update_dpp(0, __float_as_int(x), CTRL, 0xf, 0xf, true));
}
__device__ __forceinline__ float red16(float v) {
  v += dpp_mov<0x128>(v); v += dpp_mov<0x124>(v); v += dpp_mov<0x122>(v); v += dpp_mov<0x121>(v);
  return v;
}
constexpr int SCH_T = 16;
constexpr int SC_BUF = SCH_T * 5 * 64 * 4;
__device__ __forceinline__ void scan_stage(const P& p, int c, int b, int hd, int vg, int tid, LDSP char* lds) {
#pragma unroll
  for (int i = 0; i < 5; ++i) {
    const int q = i * 256 + tid;
    const int step = q / 80, rem = q % 80, vec = rem >> 4, part = rem & 15;
    const float* g = p.rw5 + (size_t)vec * L * RW + (size_t)(c * SCH_T + step) * RW + hd * 64 + part * 4;
    glds16(g, lds + b * SC_BUF + q * 16);
  }
  if (tid < 64) {
    const int step = tid >> 2, part = tid & 3;
    glds16(p.rw_v + (size_t)(c * SCH_T + step) * RW + hd * 64 + vg * 16 + part * 4, lds + 2 * SC_BUF + b * 1024 + tid * 16);
  }
}
__device__ void ph_rwkv_scan(const P& p, int item, char* smem) {
  LDSP char* lds = (LDSP char*)smem;
  const int tid = otid(), lane = tid & 63, w = tid >> 6;
  const int hd = item >> 2, vg = item & 3;
  const int rowl = w * 4 + (lane >> 4), kg = lane & 15;
  LDSP float* ybuf = (LDSP float*)(lds + 2 * SC_BUF + 2048);
  f32x4 S = (f32x4){0, 0, 0, 0};
  __builtin_amdgcn_s_setprio(3);
  __syncthreads();
  scan_stage(p, 0, 0, hd, vg, tid, lds);
  for (int c = 0; c < L / SCH_T; ++c) {
    const int b = c & 1;
    asm volatile("s_waitcnt vmcnt(0)" ::: "memory");
    __syncthreads();
    if (c + 1 < L / SCH_T) scan_stage(p, c + 1, b ^ 1, hd, vg, tid, lds);
    LDSP const char* in = lds + b * SC_BUF + kg * 16;
    LDSP const float* vb = (LDSP const float*)(lds + 2 * SC_BUF + b * 1024) + rowl;
    f32x4 kk = *(LDSP const f32x4*)(in), wv = *(LDSP const f32x4*)(in + 256), bv = *(LDSP const f32x4*)(in + 512);
    f32x4 kv = *(LDSP const f32x4*)(in + 768), rv = *(LDSP const f32x4*)(in + 1024);
    float v = vb[0];
#pragma unroll
    for (int st = 0; st < SCH_T; ++st) {
      f32x4 kk2, wv2, bv2, kv2, rv2; float v2;
      if (st + 1 < SCH_T) {
        LDSP const char* in2 = in + (st + 1) * 1280;
        kk2 = *(LDSP const f32x4*)(in2); wv2 = *(LDSP const f32x4*)(in2 + 256); bv2 = *(LDSP const f32x4*)(in2 + 512);
        kv2 = *(LDSP const f32x4*)(in2 + 768); rv2 = *(LDSP const f32x4*)(in2 + 1024); v2 = vb[(st + 1) * 16];
      }
      const f32x4 vk = kv * v;
      const f32x4 pk = S * kk;
      const float sa = -red16((pk.x + pk.y) + (pk.z + pk.w));
      S = S * wv + (bv * sa + vk);
      const f32x4 py = S * rv;
      const float y = red16((py.x + py.y) + (py.z + py.w));
      if (kg == 0) ybuf[st * 16 + rowl] = y;
      if (st + 1 < SCH_T) { kk = kk2; wv = wv2; bv = bv2; kv = kv2; rv = rv2; v = v2; }
    }
    __syncthreads();
    p.rw_y[(size_t)(c * SCH_T + (tid >> 4)) * RW + hd * 64 + vg * 16 + (tid & 15)] = ybuf[tid];
  }
  __builtin_amdgcn_s_setprio(0);
}

constexpr int CL = 64, NCH = L / CL;
constexpr int CH_ELEMS = 4096;
__device__ __forceinline__ int krow32(int s_, int h, int j) { return 16 * s_ + 8 * (j >> 2) + 4 * h + (j & 3); }
__device__ void ph_rwkv_chunk(const P& p, int bid, int nb, char* smem) {
  LDSP char* lds = (LDSP char*)smem;
  constexpr int SUB = 8, SBUF = 2 * SUB * 1280, VBUF = 2 * SUB * 256, BUFSZ = SBUF + VBUF;
  for (int item = bid; item < NCH * 3; item += nb) {
    const int tid = otid(), lane = tid & 63, w = tid >> 6;
    const int hh = w >> 1;
    const bool isB = (w & 1) != 0;
    LDSP bf16_t* outRY = (LDSP bf16_t*)(lds + 2 * BUFSZ + w * 8192);
    const int c = item / 3, hp = item - c * 3;
    const int hd = 2 * hp + hh;
    auto stage = [&](int sc, int b) {
#pragma unroll
      for (int i = 0; i < 5; ++i) {
        const int q = i * 256 + tid, h2 = q / 640, rem = q - h2 * 640, step = rem / 80, r2 = rem - step * 80, vec = r2 >> 4, part = r2 & 15;
        glds16(p.rw5 + (size_t)vec * L * RW + (size_t)(c * CL + sc * SUB + step) * RW + (2 * hp + h2) * 64 + part * 4, lds + b * BUFSZ + q * 16);
      }
      {
        const int h2 = tid >> 7, step = (tid & 127) >> 4, part = tid & 15;
        glds16(p.rw_v + (size_t)(c * CL + sc * SUB + step) * RW + (2 * hp + h2) * 64 + part * 4, lds + b * BUFSZ + SBUF + tid * 16);
      }
    };
    f32x4 row[16];
#pragma unroll
    for (int i = 0; i < 16; ++i) row[i] = (f32x4){0, 0, 0, 0};
    if (!isB) {
#pragma unroll
      for (int i = 0; i < 16; ++i)
#pragma unroll
        for (int e = 0; e < 4; ++e) row[i][e] = (lane == i * 4 + e) ? 1.f : 0.f;
    }
    __syncthreads();
    stage(0, 0);
    for (int sc = 0; sc < CL / SUB; ++sc) {
      const int b = sc & 1;
      asm volatile("s_waitcnt vmcnt(0)" ::: "memory");
      __syncthreads();
      if (sc + 1 < CL / SUB) stage(sc + 1, b ^ 1);
      LDSP const char* in = lds + b * BUFSZ + hh * (SUB * 1280);
      LDSP const float* vb = (LDSP const float*)(lds + b * BUFSZ + SBUF + hh * (SUB * 256));
#pragma unroll 1
      for (int st = 0; st < SUB; ++st) {
        LDSP const f32x4* vkk = (LDSP const f32x4*)(in + st * 1280);
        const float vi = isB ? vb[st * 64 + lane] : 0.f;
        f32x4 d0 = (f32x4){0, 0, 0, 0}, d1 = (f32x4){0, 0, 0, 0};
#pragma unroll
        for (int i = 0; i < 16; i += 2) { const f32x4 ka = vkk[i], kb = vkk[i + 1]; d0 += row[i] * ka; d1 += row[i + 1] * kb; asm volatile("" ::: "memory"); }
        d0 += d1;
        const float sa = -((d0.x + d0.y) + (d0.z + d0.w));
        f32x4 y0 = (f32x4){0, 0, 0, 0}, y1 = (f32x4){0, 0, 0, 0};
#pragma unroll
        for (int i = 0; i < 16; ++i) {
          const f32x4 wv = vkk[16 + i], bv = vkk[32 + i], kv = vkk[48 + i], rv = vkk[64 + i];
          row[i] = row[i] * wv + (bv * sa + kv * vi);
          if (i & 1) y1 += row[i] * rv; else y0 += row[i] * rv;
          if ((i & 3) == 3) asm volatile("" ::: "memory");
        }
        y0 += y1;
        outRY[(sc * SUB + st) * 64 + lane] = f2bf((y0.x + y0.y) + (y0.z + y0.w));
      }
    }
    __syncthreads();
    const size_t ch = (size_t)(c * 6 + hd) * CH_ELEMS;
    if (!isB) {
      LDSP bf16_t* mb = (LDSP bf16_t*)(lds + hh * 8192);
#pragma unroll
      for (int i = 0; i < 16; ++i) { u32x2 pk; pk.x = pack2(row[i].x, row[i].y); pk.y = pack2(row[i].z, row[i].w); *(LDSP u32x2*)(mb + lane * 64 + i * 4) = pk; }
      const int r = lane & 31, h = lane >> 5;
#pragma unroll
      for (int f = 0; f < 8; ++f) {
        const int ktp = f >> 2, kt = (f >> 1) & 1, s_ = f & 1;
        unsigned short e[8];
#pragma unroll
        for (int j = 0; j < 8; ++j) e[j] = mb[(32 * kt + krow32(s_, h, j)) * 64 + 32 * ktp + r];
        u32x4 v; v.x = e[0] | ((unsigned)e[1] << 16); v.y = e[2] | ((unsigned)e[3] << 16); v.z = e[4] | ((unsigned)e[5] << 16); v.w = e[6] | ((unsigned)e[7] << 16);
        *(u32x4*)(p.cMT + ch + (f * 64 + lane) * 8) = v;
      }
#pragma unroll
      for (int f = 0; f < 8; ++f) {
        const int it = f >> 2, kt = (f >> 1) & 1, s_ = f & 1;
        const int i = 32 * it + r, k0 = 32 * kt + 16 * s_ + 4 * h;
        const u32x2 lo = *(LDSP const u32x2*)(outRY + i * 64 + k0), hi = *(LDSP const u32x2*)(outRY + i * 64 + k0 + 8);
        u32x4 v; v.x = lo.x; v.y = lo.y; v.z = hi.x; v.w = hi.y;
        *(u32x4*)(p.cRP + ch + (f * 64 + lane) * 8) = v;
      }
    } else {
      const int vw = lane >> 5, col = lane & 31;
#pragma unroll
      for (int ktp = 0; ktp < 2; ++ktp)
#pragma unroll
        for (int g = 0; g < 4; ++g)
#pragma unroll
          for (int h = 0; h < 2; ++h) {
            const f32x4 q = row[(32 * ktp + 8 * g + 4 * h) >> 2];
            uint2 pk; pk.x = pack2(q.x, q.y); pk.y = pack2(q.z, q.w);
            *(uint2*)(p.cNT + ch + ((((vw * 2 + ktp) * 4 + g) * 64 + h * 32 + col) * 4)) = pk;
          }
      const int h = lane >> 5;
#pragma unroll
      for (int vw2 = 0; vw2 < 2; ++vw2)
#pragma unroll
        for (int it = 0; it < 2; ++it)
#pragma unroll
          for (int g = 0; g < 4; ++g) {
            const int i0 = 32 * it + 8 * g + 4 * h, v = 32 * vw2 + col;
            const unsigned e0 = outRY[(i0 + 0) * 64 + v], e1 = outRY[(i0 + 1) * 64 + v], e2 = outRY[(i0 + 2) * 64 + v], e3 = outRY[(i0 + 3) * 64 + v];
            uint2 pk; pk.x = e0 | (e1 << 16); pk.y = e2 | (e3 << 16);
            *(uint2*)(p.cY1 + ch + ((((vw2 * 2 + it) * 4 + g) * 64 + lane) * 4)) = pk;
          }
    }
  }
}

typedef float f32x16 __attribute__((ext_vector_type(16)));
__device__ void ph_rwkv_chain(const P& p, int hd, char* smem) {
  LDSP char* lds = (LDSP char*)smem;
  const int tid = otid(), lane = tid & 63, w = tid >> 6;
  const int col = lane & 31, h = lane >> 5;
  constexpr int CB = 4 * CH_ELEMS * 2;
  auto stage = [&](int c, int b) {
    const size_t ch = (size_t)(c * 6 + hd) * CH_ELEMS;
#pragma unroll
    for (int i = 0; i < 8; ++i) {
      const int q = i * 256 + tid, arr = q >> 9, off = q & 511;
      const bf16_t* src = p.cMT + (size_t)arr * ((size_t)NCH * 6 * CH_ELEMS) + ch + off * 8;
      glds16(src, lds + b * CB + q * 16);
    }
  };
  f32x16 X[2];
#pragma unroll
  for (int i = 0; i < 16; ++i) { X[0][i] = 0.f; X[1][i] = 0.f; }
  __builtin_amdgcn_s_setprio(3);
  __syncthreads();
  stage(0, 0);
  for (int c = 0; c < NCH; ++c) {
    const int b = c & 1;
    asm volatile("s_waitcnt vmcnt(0)" ::: "memory");
    __syncthreads();
    if (c + 1 < NCH) stage(c + 1, b ^ 1);
    if (w < 2) {
      const int vw = w;
      LDSP const char* base = lds + b * CB;
      bf16x8 xs[2][2];
#pragma unroll
      for (int kt = 0; kt < 2; ++kt)
#pragma unroll
        for (int s_ = 0; s_ < 2; ++s_) {
          u32x4 v;
          v.x = pack2(X[kt][8 * s_ + 0], X[kt][8 * s_ + 1]); v.y = pack2(X[kt][8 * s_ + 2], X[kt][8 * s_ + 3]);
          v.z = pack2(X[kt][8 * s_ + 4], X[kt][8 * s_ + 5]); v.w = pack2(X[kt][8 * s_ + 6], X[kt][8 * s_ + 7]);
          xs[kt][s_] = __builtin_bit_cast(bf16x8, v);
        }
#pragma unroll
      for (int it = 0; it < 2; ++it) {
        f32x16 acc;
#pragma unroll
        for (int g = 0; g < 4; ++g) {
          const u32x2 q = *(LDSP const u32x2*)(base + 3 * 8192 + ((((vw * 2 + it) * 4 + g) * 64 + lane) * 8));
          acc[4 * g + 0] = __uint_as_float(q.x << 16); acc[4 * g + 1] = __uint_as_float(q.x & 0xffff0000u);
          acc[4 * g + 2] = __uint_as_float(q.y << 16); acc[4 * g + 3] = __uint_as_float(q.y & 0xffff0000u);
        }
#pragma unroll
        for (int kt = 0; kt < 2; ++kt)
#pragma unroll
          for (int s_ = 0; s_ < 2; ++s_) {
            const bf16x8 a = *(LDSP const bf16x8*)(base + 8192 + ((((it * 2 + kt) * 2 + s_) * 64 + lane) * 16));
            acc = __builtin_amdgcn_mfma_f32_32x32x16_bf16(a, xs[kt][s_], acc, 0, 0, 0);
          }
#pragma unroll
        for (int i = 0; i < 16; ++i) {
          const int t = c * CL + 32 * it + (i & 3) + 8 * (i >> 2) + 4 * h;
          p.rw_y[(size_t)t * RW + hd * 64 + 32 * vw + col] = acc[i];
        }
      }
      f32x16 Xn[2];
#pragma unroll
      for (int ktp = 0; ktp < 2; ++ktp) {
#pragma unroll
        for (int g = 0; g < 4; ++g) {
          const u32x2 q = *(LDSP const u32x2*)(base + 2 * 8192 + ((((vw * 2 + ktp) * 4 + g) * 64 + lane) * 8));
          Xn[ktp][4 * g + 0] = __uint_as_float(q.x << 16); Xn[ktp][4 * g + 1] = __uint_as_float(q.x & 0xffff0000u);
          Xn[ktp][4 * g + 2] = __uint_as_float(q.y << 16); Xn[ktp][4 * g + 3] = __uint_as_float(q.y & 0xffff0000u);
        }
#pragma unroll
        for (int kt = 0; kt < 2; ++kt)
#pragma unroll
          for (int s_ = 0; s_ < 2; ++s_) {
            const bf16x8 a = *(LDSP const bf16x8*)(base + ((((ktp * 2 + kt) * 2 + s_) * 64 + lane) * 16));
            Xn[ktp] = __builtin_amdgcn_mfma_f32_32x32x16_bf16(a, xs[kt][s_], Xn[ktp], 0, 0, 0);
          }
      }
      X[0] = Xn[0]; X[1] = Xn[1];
    }
  }
  __builtin_amdgcn_s_setprio(0);
}

__device__ void ph_rwkv_post(const P& p, int l, int bid, int nb) {
  const int tid = otid(), lane = tid & 63, w = tid >> 6;
  const float* lg = p.rwkv_ln_g + (size_t)l * RW; const float* lb = p.rwkv_ln_b + (size_t)l * RW;
  for (int item = bid * 4 + w; item < L * 6; item += nb * 4) {
    const int t = item / 6, hd = item % 6, c = hd * 64 + lane;
    size_t o = (size_t)t * RW + c;
    float y = p.rw_y[o];
    float mean = wave_sum(y) * (1.f / 64.f);
    float d = y - mean;
    float var = wave_sum(d * d) * (1.f / 64.f);
    float on = d * rsqrtf(var + GN_EPS) * lg[c] + lb[c];
    float res = (on + p.rw_bonus[(size_t)t * 6 + hd] * p.rw_v[o]) * p.rw_g[o];
    p.mixed[(size_t)t * MXW + c] = f2bf(res);
  }
}

__device__ __forceinline__ size_t keys_rowoff(int t) {
  const int qt = t >> 7;
  return (size_t)qt * (qt + 1) / 2 * (128 * 128) + (size_t)(t & 127) * (qt + 1) * 128;
}
__device__ __forceinline__ unsigned okey16(float f) {
  unsigned u = __float_as_uint(f);
  u = (u & 0x80000000u) ? ~u : (u | 0x80000000u);
  return u >> 16;
}
__device__ void ph_idx_scores(const P& p, int bid, int nb, char* smem) {
  LDSP char* lds = (LDSP char*)smem;
  const int tid = otid(), lane = tid & 63, w = tid >> 6, wr = w >> 1, wc = w & 1;
  const int fr = lane & 15, fq = lane >> 4;
  const int srow = tid >> 3, c16 = (tid & 7) ^ (srow & 7);
  const int x7 = fr & 7;
  constexpr int NCH = (NQT + KCH - 1) / KCH;
  for (int unit = bid; unit < NQT * NCH; unit += nb) {
    const int qt = unit / NCH, ch = unit % NCH;
    if (ch * KCH > qt) continue;
    const int q0 = qt * 128;
    __syncthreads();
#pragma unroll
    for (int hd = 0; hd < 4; ++hd)
#pragma unroll
      for (int i = 0; i < 4; ++i)
        glds16(p.proj + (size_t)(q0 + i * 32 + srow) * PINP + C_IQ + hd * 64 + c16 * 8, lds + hd * 16384 + (i * 256 + tid) * 16);
    const int kt_end = min(qt + 1, (ch + 1) * KCH);
    for (int kt = ch * KCH; kt < kt_end; ++kt) {
      const int s0 = kt * 128;
      __syncthreads();
#pragma unroll
      for (int i = 0; i < 4; ++i) glds16(p.ikn + (size_t)(s0 + i * 32 + srow) * 64 + c16 * 8, lds + 65536 + (i * 256 + tid) * 16);
      asm volatile("s_waitcnt vmcnt(0)" ::: "memory");
      __syncthreads();
#pragma unroll 1
      for (int jh = 0; jh < 2; ++jh) {
        f32x4 sc[4][2];
#pragma unroll
        for (int i = 0; i < 4; ++i)
#pragma unroll
          for (int j = 0; j < 2; ++j) sc[i][j] = (f32x4){0, 0, 0, 0};
#pragma unroll 1
        for (int hd = 0; hd < 4; ++hd) {
          f32x4 acc[4][2];
#pragma unroll
          for (int i = 0; i < 4; ++i)
#pragma unroll
            for (int j = 0; j < 2; ++j) acc[i][j] = (f32x4){0, 0, 0, 0};
#pragma unroll
          for (int ks = 0; ks < 2; ++ks) {
            bf16x8 af[4], bfv[2];
            const int sw = ((ks * 4 + fq) ^ x7) << 4;
#pragma unroll
            for (int i = 0; i < 4; ++i) af[i] = *(LDSP const bf16x8*)(lds + hd * 16384 + (wr * 64 + i * 16 + fr) * 128 + sw);
#pragma unroll
            for (int j = 0; j < 2; ++j) bfv[j] = *(LDSP const bf16x8*)(lds + 65536 + (wc * 64 + (jh * 2 + j) * 16 + fr) * 128 + sw);
#pragma unroll
            for (int i = 0; i < 4; ++i)
#pragma unroll
              for (int j = 0; j < 2; ++j) acc[i][j] = __builtin_amdgcn_mfma_f32_16x16x32_bf16(bfv[j], af[i], acc[i][j], 0, 0, 0);
          }
#pragma unroll
          for (int i = 0; i < 4; ++i) {
            const float wg = p.iws[(size_t)(q0 + wr * 64 + i * 16 + fr) * 4 + hd];
#pragma unroll
            for (int j = 0; j < 2; ++j) {
              sc[i][j][0] += fmaxf(acc[i][j][0], 0.f) * wg; sc[i][j][1] += fmaxf(acc[i][j][1], 0.f) * wg;
              sc[i][j][2] += fmaxf(acc[i][j][2], 0.f) * wg; sc[i][j][3] += fmaxf(acc[i][j][3], 0.f) * wg;
            }
          }
        }
#pragma unroll
        for (int i = 0; i < 4; ++i) {
          const int q = q0 + wr * 64 + i * 16 + fr;
          bf16_t* kr = p.keys + keys_rowoff(q) + s0 + wc * 64 + jh * 32 + fq * 4;
#pragma unroll
          for (int j = 0; j < 2; ++j) {
            uint2 pk;
            pk.x = okey16(sc[i][j][0]) | (okey16(sc[i][j][1]) << 16);
            pk.y = okey16(sc[i][j][2]) | (okey16(sc[i][j][3]) << 16);
            *(uint2*)(kr + j * 16) = pk;
          }
        }
      }
    }
  }
}

__device__ __forceinline__ unsigned block_excl_scan(unsigned v, volatile unsigned* tot4, int lane, int w) {
  unsigned x = v;
#pragma unroll
  for (int o = 1; o < 64; o <<= 1) { const unsigned y = __shfl_up(x, o); if (lane >= o) x += y; }
  __syncthreads();
  if (lane == 63) tot4[w] = x;
  __syncthreads();
  unsigned base = 0;
#pragma unroll
  for (int i = 0; i < 3; ++i) base += (i < w) ? tot4[i] : 0u;
  return base + x - v;
}
__device__ void ph_topk(const P& p, int bid, int nb, char* smem) {
  bf16_t* keys = (bf16_t*)smem;
  unsigned* hist = (unsigned*)(smem + 32768);
  unsigned* misc = hist + 256;
  unsigned* tot4 = misc + 8;
  const int tid = otid(), lane = tid & 63, w = tid >> 6;
  for (int t = bid; t < L; t += nb) {
    const int n = t + 1;
    int* out = p.idx + (size_t)t * TOPK;
    if (n <= TOPK) { out[tid] = (tid < n) ? tid : 0; continue; }
    __syncthreads();
    const bf16_t* krow = p.keys + keys_rowoff(t);
    const int n8 = (n + 7) >> 3;
    for (int i = tid; i < n8; i += 256) *(uint4*)(keys + i * 8) = *(const uint4*)(krow + i * 8);
    unsigned prefix = 0, mask = 0; int need = TOPK;
    for (int pass = 0; pass < 2; ++pass) {
      const int shift = 8 - 8 * pass;
      hist[tid] = 0;
      __syncthreads();
      for (int i = tid; i < n; i += 256) { unsigned k = keys[i]; if ((k & mask) == prefix) atomicAdd(&hist[(k >> shift) & 255u], 1u); }
      __syncthreads();
      const unsigned hb = hist[255 - tid];
      const unsigned above = block_excl_scan(hb, tot4, lane, w);
      if ((int)above < need && need <= (int)(above + hb)) { misc[0] = (unsigned)(255 - tid); misc[1] = (unsigned)(need - (int)above); }
      __syncthreads();
      prefix |= misc[0] << shift; mask |= 0xFFu << shift; need = (int)misc[1];
      __syncthreads();
    }
    const int ngt = TOPK - need;
    const int per = (n + 255) / 256;
    const int i0 = tid * per, i1 = min(n, i0 + per);
    int ceq = 0, cgt = 0;
    for (int i = i0; i < i1; ++i) { const unsigned k = keys[i]; ceq += (k == prefix); cgt += (k > prefix); }
    const unsigned pk = block_excl_scan((unsigned)ceq | ((unsigned)cgt << 16), tot4, lane, w);
    int erank = (int)(pk & 0xffffu), grank = (int)(pk >> 16);
    for (int i = i0; i < i1; ++i) {
      const unsigned k = keys[i];
      if (k > prefix) { out[grank] = i; ++grank; }
      else if (k == prefix) { if (erank < need) out[ngt + erank] = i; ++erank; }
    }
  }
}

__device__ __forceinline__ float dot2bf(unsigned a, unsigned b, float c) {
  return __builtin_amdgcn_fdot2_f32_bf16(__builtin_bit_cast(bf16x2_t, a), __builtin_bit_cast(bf16x2_t, b), c, false);
}
__device__ void ph_dsa_attn(const P& p, int l, int bid, int nb, char* smem) {
  const int tid = otid(), lane = tid & 63, w = tid >> 6;
  LDSP char* wl = (LDSP char*)smem + w * 8192;
  LDSP unsigned* ql2 = (LDSP unsigned*)wl;
  LDSP f32x4* pl = (LDSP f32x4*)(wl + 1024);
  for (int t = bid * 4 + w; t < L; t += nb * 4) {
    const int cnt = min(TOPK, t + 1);
    {
      const f32x4 a = *(const f32x4*)(p.qlat + (size_t)t * 512 + lane * 4);
      const f32x4 b = *(const f32x4*)(p.qlat + (size_t)t * 512 + 256 + lane * 4);
      ql2[lane * 2] = pack2(a.x, a.y); ql2[lane * 2 + 1] = pack2(a.z, a.w);
      ql2[128 + lane * 2] = pack2(b.x, b.y); ql2[128 + lane * 2 + 1] = pack2(b.z, b.w);
    }
    int id[4];
#pragma unroll
    for (int i = 0; i < 4; ++i) id[i] = (lane + 64 * i < cnt) ? p.idx[(size_t)t * TOPK + lane + 64 * i] : 0;
    float lg[4][4];
#pragma unroll
    for (int i = 0; i < 4; ++i)
#pragma unroll
      for (int hd = 0; hd < 4; ++hd) lg[i][hd] = 0.f;
#pragma unroll 2
    for (int c = 0; c < 16; ++c) {
      u32x4 kv[4];
#pragma unroll
      for (int i = 0; i < 4; ++i) kv[i] = *(const u32x4*)(p.ckvb + (size_t)id[i] * KVL + c * 8);
#pragma unroll
      for (int hd = 0; hd < 4; ++hd) {
        const u32x4 q = *(LDSP const u32x4*)(ql2 + hd * 64 + c * 4);
#pragma unroll
        for (int i = 0; i < 4; ++i) {
          float a = lg[i][hd];
          a = dot2bf(kv[i].x, q.x, a); a = dot2bf(kv[i].y, q.y, a); a = dot2bf(kv[i].z, q.z, a); a = dot2bf(kv[i].w, q.w, a);
          lg[i][hd] = a;
        }
      }
    }
    float mx[4], sm[4];
#pragma unroll
    for (int hd = 0; hd < 4; ++hd) {
      const float slope = exp2f(-8.0f * (float)(6 + hd + 1) / 10.0f);
      float m = -INFINITY;
#pragma unroll
      for (int i = 0; i < 4; ++i) {
        const bool valid = (lane + 64 * i) < cnt;
        lg[i][hd] = valid ? (lg[i][hd] - slope * (float)(t - id[i])) : -INFINITY;
        m = fmaxf(m, lg[i][hd]);
      }
      mx[hd] = wave_max(m);
      float sacc = 0.f;
#pragma unroll
      for (int i = 0; i < 4; ++i) { lg[i][hd] = expf(lg[i][hd] - mx[hd]); sacc += lg[i][hd]; }
      sm[hd] = 1.f / wave_sum(sacc);
    }
#pragma unroll
    for (int i = 0; i < 4; ++i) pl[lane + 64 * i] = (f32x4){lg[i][0] * sm[0], lg[i][1] * sm[1], lg[i][2] * sm[2], lg[i][3] * sm[3]};
    float o[4][2];
#pragma unroll
    for (int hd = 0; hd < 4; ++hd) { o[hd][0] = 0.f; o[hd][1] = 0.f; }
#pragma unroll
    for (int i = 0; i < 4; ++i) {
      const int kend = min(64, cnt - 64 * i);
#pragma unroll 8
      for (int kk = 0; kk < kend; ++kk) {
        const int kid = __builtin_amdgcn_readlane(id[i], kk);
        const unsigned cv = *(const unsigned*)(p.ckvb + (size_t)kid * KVL + lane * 2);
        const f32x4 pv = pl[64 * i + kk];
        const float c0 = __uint_as_float(cv << 16), c1 = __uint_as_float(cv & 0xffff0000u);
        o[0][0] += pv.x * c0; o[0][1] += pv.x * c1; o[1][0] += pv.y * c0; o[1][1] += pv.y * c1;
        o[2][0] += pv.z * c0; o[2][1] += pv.z * c1; o[3][0] += pv.w * c0; o[3][1] += pv.w * c1;
      }
    }
#pragma unroll
    for (int hd = 0; hd < 4; ++hd)
      *(unsigned*)(p.mixed + (size_t)t * MXW + MX_DSA + hd * KVL + lane * 2) = pack2(o[hd][0], o[hd][1]);
  }
}

__device__ __forceinline__ float rmax16(float v) {
  v = fmaxf(v, dpp_mov<0x128>(v)); v = fmaxf(v, dpp_mov<0x124>(v)); v = fmaxf(v, dpp_mov<0x122>(v)); v = fmaxf(v, dpp_mov<0x121>(v));
  return v;
}
constexpr int SW_VTROW = 432, SW_PROW = 336;
__device__ void ph_swa(const P& p, int l, int bid, int nb, char* smem) {
  LDSP char* lds = (LDSP char*)smem;
  const int tid = otid(), lane = tid & 63, w = tid >> 6, fr = lane & 15, fq = lane >> 4;
  LDSP char* Ks = lds;
  LDSP char* VT = lds + 24576;
  LDSP char* Pw = lds + 24576 + 64 * SW_VTROW + w * (16 * SW_PROW);
  const float* sinks = p.swa_sinks + (size_t)l * 6;
  for (int item = bid; item < (L / 64) * 2; item += nb) {
    const int qt = item >> 1, g = item & 1, t0 = qt * 64, kb0 = t0 - 128;
    __syncthreads();
#pragma unroll
    for (int i = 0; i < 6; ++i) {
      const int q = i * 256 + tid, row = q >> 3, c16 = (q & 7) ^ (row & 7);
      const int sr = max(kb0 + row, 0);
      glds16(p.proj + (size_t)sr * PINP + C_SK + g * 64 + c16 * 8, Ks + q * 16);
    }
#pragma unroll
    for (int i = 0; i < 6; ++i) {
      const int q = i * 256 + tid, c = q / 192, row = q - c * 192;
      const int sr = max(kb0 + row, 0);
      const u32x4 v = *(const u32x4*)(p.proj + (size_t)sr * PINP + C_SV + g * 64 + c * 8);
      LDSP bf16_t* d = (LDSP bf16_t*)(VT + (c * 8) * SW_VTROW + row * 2);
      d[0 * (SW_VTROW / 2)] = (bf16_t)(v.x & 0xffffu); d[1 * (SW_VTROW / 2)] = (bf16_t)(v.x >> 16);
      d[2 * (SW_VTROW / 2)] = (bf16_t)(v.y & 0xffffu); d[3 * (SW_VTROW / 2)] = (bf16_t)(v.y >> 16);
      d[4 * (SW_VTROW / 2)] = (bf16_t)(v.z & 0xffffu); d[5 * (SW_VTROW / 2)] = (bf16_t)(v.z >> 16);
      d[6 * (SW_VTROW / 2)] = (bf16_t)(v.w & 0xffffu); d[7 * (SW_VTROW / 2)] = (bf16_t)(v.w >> 16);
    }
    for (int i = tid; i < 64 * 12; i += 256) *(LDSP unsigned*)(VT + (i / 12) * SW_VTROW + 384 + (i % 12) * 4) = 0u;
    for (int i = lane; i < 16 * 12; i += 64) *(LDSP unsigned*)(Pw + (i / 12) * SW_PROW + 288 + (i % 12) * 4) = 0u;
    asm volatile("s_waitcnt vmcnt(0)" ::: "memory");
    __syncthreads();
    const int tq = t0 + 16 * w;
#pragma unroll 1
    for (int hh = 0; hh < 3; ++hh) {
      const int hq = g * 3 + hh;
      const float slope = exp2f(-8.0f * (float)(hq + 1) / 10.0f);
      const float sink = sinks[hq];
      bf16x8 qf[2];
#pragma unroll
      for (int ks = 0; ks < 2; ++ks) qf[ks] = *(const bf16x8*)(p.proj + (size_t)(tq + fr) * PINP + C_SQ + hq * 64 + ks * 32 + fq * 8);
      float lg[9][4];
      float mx[4] = {-INFINITY, -INFINITY, -INFINITY, -INFINITY};
#pragma unroll
      for (int j = 0; j < 9; ++j) {
        const int krow = 16 * w + 16 * j + fr;
        f32x4 acc = (f32x4){0, 0, 0, 0};
#pragma unroll
        for (int ks = 0; ks < 2; ++ks) {
          const bf16x8 kf = *(LDSP const bf16x8*)(Ks + krow * 128 + (((ks * 4 + fq) ^ (krow & 7)) << 4));
          acc = __builtin_amdgcn_mfma_f32_16x16x32_bf16(qf[ks], kf, acc, 0, 0, 0);
        }
        const int sk = kb0 + krow;
#pragma unroll
        for (int r = 0; r < 4; ++r) {
          const int dist = 128 - 16 * j + fq * 4 + r - fr;
          const bool valid = (dist >= 0) && (dist < 128) && (sk >= 0);
          const float v = valid ? (acc[r] * 0.125f - slope * (float)dist) : -INFINITY;
          lg[j][r] = v; mx[r] = fmaxf(mx[r], v);
        }
      }
      float inv[4];
#pragma unroll
      for (int r = 0; r < 4; ++r) {
        const float m = fmaxf(rmax16(mx[r]), sink);
        float sacc = 0.f;
#pragma unroll
        for (int j = 0; j < 9; ++j) { lg[j][r] = expf(lg[j][r] - m); sacc += lg[j][r]; }
        inv[r] = 1.f / (red16(sacc) + expf(sink - m));
      }
#pragma unroll
      for (int j = 0; j < 9; ++j)
#pragma unroll
        for (int r = 0; r < 4; ++r) *(LDSP bf16_t*)(Pw + (fq * 4 + r) * SW_PROW + (16 * j + fr) * 2) = f2bf(lg[j][r] * inv[r]);
#pragma unroll
      for (int nt = 0; nt < 4; ++nt) {
        f32x4 acc = (f32x4){0, 0, 0, 0};
#pragma unroll
        for (int ks = 0; ks < 5; ++ks) {
          const bf16x8 vf = *(LDSP const bf16x8*)(VT + (nt * 16 + fr) * SW_VTROW + (16 * w + ks * 32 + fq * 8) * 2);
          const bf16x8 pf = *(LDSP const bf16x8*)(Pw + fr * SW_PROW + (ks * 32 + fq * 8) * 2);
          acc = __builtin_amdgcn_mfma_f32_16x16x32_bf16(vf, pf, acc, 0, 0, 0);
        }
        uint2 pk; pk.x = pack2(acc[0], acc[1]); pk.y = pack2(acc[2], acc[3]);
        *(uint2*)(p.mixed + (size_t)(tq + fr) * MXW + MX_SWA + hq * 64 + nt * 16 + fq * 4) = pk;
      }
    }
  }
}

template <bool COMBINE>
__device__ void ph_ln(const P& p, const float* xin, const float* gatev, const float* lng, const float* lnb,
                      float* xout, const float* nsh, const float* nsc, bf16_t* hout, float* hfout, int bid, int nb, char* smem) {
  float* red = (float*)smem;
  const int tid = otid(), lane = tid & 63, w = tid >> 6;
  const int c = tid * 4;
  for (int t = bid; t < L; t += nb) {
    f32x4 xv = *(const f32x4*)(xin + (size_t)t * D + c);
    f32x4 y;
    if (COMBINE) {
      f32x4 r = (f32x4){0, 0, 0, 0};
      for (int k = 0; k < TOPE + 1; ++k) {
        const int slot = (k < TOPE) ? p.pos[(size_t)t * TOPE + k] : (p.offs[NE] + t);
        uint2 ov = *(const uint2*)(p.osort + (size_t)slot * D + c);
        r.x += __uint_as_float(ov.x << 16); r.y += __uint_as_float(ov.x & 0xffff0000u);
        r.z += __uint_as_float(ov.y << 16); r.w += __uint_as_float(ov.y & 0xffff0000u);
      }
      y = r;
    } else {
      y = *(const f32x4*)(p.tmp + (size_t)t * D + c);
    }
    f32x4 gv = *(const f32x4*)(gatev + c);
    f32x4 v = xv * ALPHA + gv * y;
    float s = wave_sum(v.x + v.y + v.z + v.w);
    __syncthreads();
    if (lane == 0) red[w] = s;
    __syncthreads();
    const float mean = (red[0] + red[1] + red[2] + red[3]) * (1.f / D);
    f32x4 d = v - mean;
    float q = wave_sum(d.x * d.x + d.y * d.y + d.z * d.z + d.w * d.w);
    if (lane == 0) red[4 + w] = q;
    __syncthreads();
    const float var = (red[4] + red[5] + red[6] + red[7]) * (1.f / D);
    const float rs = rsqrtf(var + LN_EPS);
    f32x4 gg = *(const f32x4*)(lng + c), bb = *(const f32x4*)(lnb + c);
    f32x4 o = d * rs * gg + bb;
    *(f32x4*)(xout + (size_t)t * D + c) = o;
    if (hout) {
      f32x4 sc = *(const f32x4*)(nsc + c), sh = *(const f32x4*)(nsh + c);
      f32x4 hv = o * (sc + 1.f) + sh;
      uint2 pk; pk.x = pack2(hv.x, hv.y); pk.y = pack2(hv.z, hv.w);
      *(uint2*)(hout + (size_t)t * D + c) = pk;
      if (hfout) *(f32x4*)(hfout + (size_t)t * D + c) = hv;
    }
  }
}

__device__ void ph_route(const P& p, int l, int bid, int nb, char* smem) {
  const int tid = otid(), lane = tid & 63, w = tid >> 6;
  float* sel = (float*)smem + w * 128;
  float* gs = sel + 64;
  const float* bias = p.router_bias + (size_t)l * NE;
  int* cnt = p.cnt + l * NE;
  for (int i = bid * 256 + tid; i < CAPR; i += nb * 256) p.slot_tok[i] = L;
  for (int t = bid * 4 + w; t < L; t += nb * 4) {
    const float score = sigmoidf_(p.logits[(size_t)t * NE + lane]);
    const float sv = score + bias[lane];
    sel[lane] = sv;
    const int g = lane >> 3;
    int rg = 0;
#pragma unroll
    for (int j = 0; j < 8; ++j) { const int o = g * 8 + j; const float ov = sel[o]; rg += (ov > sv || (ov == sv && o < lane)) ? 1 : 0; }
    float contrib = (rg < 2) ? sv : 0.f;
    contrib += __shfl_xor(contrib, 1); contrib += __shfl_xor(contrib, 2); contrib += __shfl_xor(contrib, 4);
    if ((lane & 7) == 0) gs[g] = contrib;
    const float mygs = contrib;
    int grank = 0;
#pragma unroll
    for (int j = 0; j < 8; ++j) { const float ov = gs[j]; grank += (ov > mygs || (ov == mygs && j < g)) ? 1 : 0; }
    const float sv2 = (grank < 4) ? sv : -1e30f;
    sel[lane] = sv2;
    int rk = 0;
    for (int j = 0; j < 64; ++j) { const float ov = sel[j]; rk += (ov > sv2 || (ov == sv2 && j < lane)) ? 1 : 0; }
    const bool chosen = rk < TOPE;
    const float ssum = wave_sum(chosen ? score : 0.f);
    if (chosen) {
      const float gt = score / ssum * 2.5f;
      const int er = atomicAdd(&cnt[lane], 1);
      p.eidx[(size_t)t * TOPE + rk] = lane;
      p.gate[(size_t)t * TOPE + rk] = gt;
      p.erank[(size_t)t * TOPE + rk] = er;
    }
  }
}

__device__ void ph_moe_scatter(const P& p, int l, int bid, int nb, char* smem) {
  int* soffs = (int*)smem;
  __syncthreads();
  if (otid() == 0) {
    const int* cnt = p.cnt + l * NE;
    int off = 0, nt = 0;
    for (int e = 0; e < NE; ++e) {
      soffs[e] = off;
      const int tl = (cnt[e] + MT - 1) / MT;
      if (bid == 0) { p.offs[e] = off; for (int i = 0; i < tl; ++i) p.tile_e[nt + i] = e; }
      nt += tl; off += tl * MT;
    }
    soffs[NE] = off;
    if (bid == 0) {
      p.offs[NE] = off;
      for (int i = 0; i < L / MT; ++i) p.tile_e[nt + i] = NE;
      *p.ntm = nt + L / MT;
    }
  }
  __syncthreads();
  for (int i = bid * 256 + otid(); i < L * TOPE; i += nb * 256) {
    const int e = p.eidx[i];
    const int slot = soffs[e] + p.erank[i];
    p.slot_tok[slot] = i / TOPE;
    p.slot_gate[slot] = p.gate[i];
    p.pos[i] = slot;
  }
  const int so = soffs[NE];
  for (int i = bid * 256 + otid(); i < L; i += nb * 256) { p.slot_tok[so + i] = i; p.slot_gate[so + i] = 1.0f; }
}

__device__ __forceinline__ void gbar(unsigned* ctr, unsigned& epoch) {
  epoch += gridDim.x;
  asm volatile("s_waitcnt vmcnt(0)" ::: "memory");
  __syncthreads();
  if (otid() == 0) {
    __builtin_amdgcn_fence(__ATOMIC_RELEASE, "agent");
    asm volatile("s_waitcnt vmcnt(0)" ::: "memory");
    __hip_atomic_fetch_add(ctr, 1u, __ATOMIC_RELAXED, __HIP_MEMORY_SCOPE_AGENT);
    while (__hip_atomic_load(ctr, __ATOMIC_RELAXED, __HIP_MEMORY_SCOPE_AGENT) < epoch) __builtin_amdgcn_s_sleep(2);
    __builtin_amdgcn_fence(__ATOMIC_ACQUIRE, "agent");
    asm volatile("s_waitcnt vmcnt(0)" ::: "memory");
  }
  __syncthreads();
}

constexpr int SMEM_BYTES = 81920;
constexpr int NSCAN = 6;
#ifndef RPS
#define RPS 0
#endif
#ifndef REPS
#define REPS 0,0,0,0,0,0,0
#endif
constexpr int RP[7] = {REPS};

__global__ void __launch_bounds__(256, 2) mega(P p, unsigned* bar) {
  __shared__ __attribute__((aligned(16))) char smem[SMEM_BYTES];
  cg::grid_group grid = cg::this_grid();
  const int bid = blockIdx.x, nb = gridDim.x;
  unsigned epoch = 0;
  ph_mod(p, bid, nb, smem);
  grid.sync();
  ph_hmod(p, p.x, p.mod + 0, p.mod + D, p.h, bid, nb);
  ph_convert(p, 0, bid, nb, smem);
  gbar(bar, epoch);
  for (int l = 0; l < DEPTH; ++l) {
    const float* mod = p.mod + (size_t)l * 6 * D;
    {
      BG g{}; g.A = p.h; g.lda = D; g.Bt = p.wb_in; g.K = D; g.C = p.proj; g.ldc = PINP; g.ntm = L / 128; g.ntn = PINP / 128;
      for (int r = 0; r <= RP[0]; ++r) ph_bgemm<0>(g, bid, nb, smem);
    }
    gbar(bar, epoch);
    ph_pre1(p, l, bid, nb);
    gbar(bar, epoch);
    {
      BG g{}; g.lda = 256; g.ldc = 3 * RW; g.ntm = L / 128; g.ntn = 3;
      g.A = p.loraA; g.Bt = p.wb_w2; g.K = 64; g.C = p.lacc; ph_bgemm<1>(g, bid, nb, smem);
      g.A = p.loraA + 64; g.Bt = p.wb_a2; g.K = 64; g.C = p.lacc + RW; ph_bgemm<1>(g, bid, nb, smem);
      g.A = p.loraA + 128; g.Bt = p.wb_g2; g.K = 128; g.C = p.lacc + 2 * RW; ph_bgemm<1>(g, bid, nb, smem);
      g.lda = PINP; g.ldc = 512; g.ntn = 1; g.K = 64;
      for (int hd = 0; hd < 4; ++hd) { g.A = p.proj + C_DQ + hd * 64; g.Bt = p.wb_uk + (size_t)hd * KVL * 64; g.C = p.qlat + hd * KVL; ph_bgemm<1>(g, bid, nb, smem); }
    }
    gbar(bar, epoch);
    ph_pre3(p, l, bid, nb);
    gbar(bar, epoch);
    ph_rwkv_chunk(p, bid, nb, smem);
    gbar(bar, epoch);
    if (bid < NSCAN) { for (int r = 0; r <= RPS; ++r) ph_rwkv_chain(p, bid, smem); }
    else { for (int r = 0; r <= RP[6]; ++r) { ph_idx_scores(p, bid - NSCAN, nb - NSCAN, smem); ph_swa(p, l, bid - NSCAN, nb - NSCAN, smem); } }
    gbar(bar, epoch);
    for (int r = 0; r <= RP[2]; ++r) { ph_topk(p, bid, nb, smem); ph_rwkv_post(p, l, bid, nb); }
    gbar(bar, epoch);
    for (int r = 0; r <= RP[3]; ++r) ph_dsa_attn(p, l, bid, nb, smem);
    gbar(bar, epoch);
    {
      BG g{}; g.A = p.mixed; g.lda = MXW; g.Bt = p.wb_out; g.K = MXW; g.C = p.tmp; g.ldc = D; g.ntm = L / 128; g.ntn = D / 128;
      for (int r = 0; r <= RP[0]; ++r) ph_bgemm<1>(g, bid, nb, smem);
    }
    gbar(bar, epoch);
    {
      const float* xin = (l == 0) ? p.x : p.xb;
      ph_ln<false>(p, xin, mod + 2 * D, p.ln_mix_g + (size_t)l * D, p.ln_mix_b + (size_t)l * D, p.xa, mod + 3 * D, mod + 4 * D, p.h, p.hf, bid, nb, smem);
    }
    gbar(bar, epoch);
    ph_router_gemm(p, l, bid, nb, smem);
    gbar(bar, epoch);
    ph_route(p, l, bid, nb, smem);
    gbar(bar, epoch);
    ph_moe_scatter(p, l, bid, nb, smem);
    gbar(bar, epoch);
    {
      BG g{}; g.A = p.h; g.lda = D; g.rowidx = p.slot_tok; g.Bt = p.wb_up; g.bstride = (long)512 * D; g.tile_e = p.tile_e; g.K = D;
      g.C = p.hid; g.ldc = DE; g.ntm_ptr = p.ntm; g.ntn = 4;
      for (int r = 0; r <= RP[4]; ++r) ph_bgemm<2>(g, bid, nb, smem);
    }
    gbar(bar, epoch);
    {
      BG g{}; g.A = p.hid; g.lda = DE; g.Bt = p.wb_dn; g.bstride = (long)D * DE; g.tile_e = p.tile_e; g.K = DE;
      g.C = p.osort; g.ldc = D; g.rowscale = p.slot_gate; g.ntm_ptr = p.ntm; g.ntn = D / 128;
      for (int r = 0; r <= RP[4]; ++r) ph_bgemm<3>(g, bid, nb, smem);
    }
    gbar(bar, epoch);
    {
      const bool last = (l == DEPTH - 1);
      const float* nmod = mod + 6 * D;
      for (int r = 0; r <= RP[5]; ++r) {
      ph_ln<true>(p, p.xa, mod + 5 * D, p.ln_ffn_g + (size_t)l * D, p.ln_ffn_b + (size_t)l * D, last ? p.out : p.xb,
                  nmod + 0, nmod + D, last ? nullptr : p.h, nullptr, bid, nb, smem);
      if (!last) ph_convert(p, l + 1, bid, nb, smem);
      }
    }
    if (l + 1 < DEPTH) gbar(bar, epoch);
  }
}

static inline char* carve(char*& cur, size_t bytes) { char* r = cur; cur += (bytes + 255) & ~(size_t)255; return r; }

extern "C" void kernel_launch(void* const* d_in, const int* in_sizes, int n_in,
                              void* d_out, int out_size, void* d_ws, size_t ws_size,
                              hipStream_t stream) {
  P p{};
  const float** ins = (const float**)&p.x;
  for (int i = 0; i < 35; ++i) ins[i] = (const float*)d_in[i];
  p.out = (float*)d_out;
  char* cur = (char*)d_ws;
  p.cnt = (int*)carve(cur, DEPTH * NE * 4);
  p.offs = (int*)carve(cur, (NE + 1) * 4);
  p.ntm = (int*)carve(cur, 4);
  p.tile_e = (int*)carve(cur, MAXTILES * 4);
  p.mod = (float*)carve(cur, (size_t)(DEPTH + 1) * 6 * D * 4);
  p.wb_in = (bf16_t*)carve(cur, (size_t)PINP * D * 2);
  p.wb_out = (bf16_t*)carve(cur, (size_t)D * MXW * 2);
  p.wb_w2 = (bf16_t*)carve(cur, (size_t)RW * 64 * 2);
  p.wb_a2 = (bf16_t*)carve(cur, (size_t)RW * 64 * 2);
  p.wb_g2 = (bf16_t*)carve(cur, (size_t)RW * 128 * 2);
  p.wb_uk = (bf16_t*)carve(cur, (size_t)4 * KVL * 64 * 2);
  p.wb_up = (bf16_t*)carve(cur, (size_t)NEX * 512 * D * 2);
  p.wb_dn = (bf16_t*)carve(cur, (size_t)NEX * D * DE * 2);
  p.h = (bf16_t*)carve(cur, (size_t)(L + 1) * D * 2);
  p.hf = (float*)carve(cur, (size_t)L * D * 4);
  p.mixed = (bf16_t*)carve(cur, (size_t)L * MXW * 2);
  p.xa = (float*)carve(cur, (size_t)L * D * 4);
  p.xb = (float*)carve(cur, (size_t)L * D * 4);
  p.logits = (float*)carve(cur, (size_t)L * NE * 4);
  p.gate = (float*)carve(cur, (size_t)L * TOPE * 4);
  p.eidx = (int*)carve(cur, (size_t)L * TOPE * 4);
  p.erank = (int*)carve(cur, (size_t)L * TOPE * 4);
  p.pos = (int*)carve(cur, (size_t)L * TOPE * 4);
  p.slot_tok = (int*)carve(cur, (size_t)CAP * 4);
  p.slot_gate = (float*)carve(cur, (size_t)CAP * 4);
  char* ov = cur;
  p.proj = (bf16_t*)carve(cur, (size_t)L * PINP * 2);
  p.tmp = (float*)p.proj;
  p.rw5 = (float*)carve(cur, (size_t)5 * L * RW * 4);
  p.rw_kk = p.rw5; p.rw_w = p.rw5 + (size_t)L * RW; p.rw_b = p.rw5 + (size_t)2 * L * RW; p.rw_k = p.rw5 + (size_t)3 * L * RW; p.rw_r = p.rw5 + (size_t)4 * L * RW;
  p.rw_v = (float*)carve(cur, (size_t)L * RW * 4);
  p.rw_g = (float*)carve(cur, (size_t)L * RW * 4);
  p.cMT = (bf16_t*)carve(cur, (size_t)4 * NCH * 6 * CH_ELEMS * 2);
  p.cRP = p.cMT + (size_t)NCH * 6 * CH_ELEMS; p.cNT = p.cRP + (size_t)NCH * 6 * CH_ELEMS; p.cY1 = p.cNT + (size_t)NCH * 6 * CH_ELEMS;
  p.rw_y = (float*)carve(cur, (size_t)L * RW * 4);
  p.rw_bonus = (float*)carve(cur, (size_t)L * 6 * 4);
  p.ckvb = (bf16_t*)carve(cur, (size_t)L * KVL * 2);
  p.qlat = (float*)carve(cur, (size_t)L * 512 * 4);
  p.ikn = (bf16_t*)carve(cur, (size_t)L * 64 * 2);
  p.iws = (float*)carve(cur, (size_t)L * 4 * 4);
  p.idx = (int*)carve(cur, (size_t)L * TOPK * 4);
  p.keys = (bf16_t*)carve(cur, (size_t)NQT * (NQT + 1) / 2 * 128 * 128 * 2);
  p.lacc = (float*)p.keys;
  p.loraA = (bf16_t*)((char*)p.keys + (size_t)L * 3 * RW * 4);
  char* ovend = cur;
  char* cur2 = ov;
  p.hid = (bf16_t*)carve(cur2, (size_t)CAP * DE * 2);
  p.osort = (bf16_t*)carve(cur2, (size_t)CAP * D * 2);
  if (cur2 > ovend) ovend = cur2;
  if ((size_t)(ovend - (char*)d_ws) > ws_size) { fprintf(stderr, "workspace too small: need %zu have %zu\n", (size_t)(ovend - (char*)d_ws), ws_size); return; }
  cur = ovend;

  unsigned* bar = (unsigned*)carve(cur, 256);
  if ((size_t)(cur - (char*)d_ws) > ws_size) { fprintf(stderr, "workspace too small\n"); return; }
  hipMemsetAsync(p.cnt, 0, DEPTH * NE * 4, stream);
  hipMemsetAsync(bar, 0, 256, stream);
  static int grid_blocks = 0;
  if (!grid_blocks) {
    int dev = 0, cus = 0, per_cu = 0;
    (void)hipGetDevice(&dev);
    (void)hipDeviceGetAttribute(&cus, hipDeviceAttributeMultiprocessorCount, dev);
    (void)hipOccupancyMaxActiveBlocksPerMultiprocessor(&per_cu, mega, 256, 0);
    if (per_cu > 2) per_cu = 2;
    if (per_cu < 1) per_cu = 1;
    grid_blocks = cus * per_cu;
  }
  void* args[] = {&p, &bar};
  hipError_t e = hipLaunchCooperativeKernel((void*)mega, dim3(grid_blocks), dim3(256), args, 0, stream);
  if (e != hipSuccess) fprintf(stderr, "cooperative launch failed: %s (grid %d)\n", hipGetErrorString(e), grid_blocks);
}
```

```cpp
#include <hip/hip_runtime.h>
#include <hip/hip_cooperative_groups.h>
#include <cstdio>
#include <cstdint>
namespace cg = cooperative_groups;

constexpr int L = 16384, D = 1024, DEPTH = 4;
constexpr int RW = 384, DSW = 256, SWW = 384;
constexpr int NRWC = 1408, PIN = 2756, PINP = 2816;
constexpr int C_R = 0, C_K = 384, C_V = 768, C_WL = 1152, C_AL = 1216, C_GL = 1280;
constexpr int C_DQ = 1408, C_CKV = 1664, C_IQ = 1792, C_IK = 2048, C_IW = 2112;
constexpr int C_SQ = 2120, C_SK = 2504, C_SV = 2632;
constexpr int KVL = 128, TOPK = 256;
constexpr int NE = 64, NEX = 65, TOPE = 8, DE = 256;
constexpr int MT = 128;
constexpr int CAPR = L * TOPE + NE * MT;
constexpr int CAP = CAPR + L;
constexpr int MAXTILES = CAP / MT;
constexpr float ALPHA = 1.681792830507429f;
constexpr float LN_EPS = 1e-5f, GN_EPS = 64e-5f;
constexpr int NQT = L / 128;
constexpr int KCH = 8;
constexpr int MXW = 1280;
constexpr int MX_DSA = 384, MX_SWA = 896;

typedef float f32x4 __attribute__((ext_vector_type(4)));
typedef short bf16x8 __attribute__((ext_vector_type(8)));
typedef unsigned short bf16_t;
typedef unsigned u32x4 __attribute__((ext_vector_type(4)));
typedef unsigned u32x2 __attribute__((ext_vector_type(2)));
typedef __bf16 bf16x2_t __attribute__((ext_vector_type(2)));
#define LDSP __attribute__((address_space(3)))

struct P {
  const float *x, *c, *w_mod, *b_mod, *w_in, *rwkv_mu, *rwkv_w0, *rwkv_w2, *rwkv_a0, *rwkv_a2, *rwkv_g2;
  const float *rwkv_k_k, *rwkv_k_a, *rwkv_r_k, *rwkv_ln_g, *rwkv_ln_b, *dsa_kv_norm, *dsa_w_uk, *dsa_w_uv;
  const float *dsa_ik_g, *dsa_ik_b, *swa_sinks, *w_out, *ln_mix_g, *ln_mix_b, *router_w, *router_bias;
  const float *exp_w1, *exp_w3, *exp_w2, *sh_w1, *sh_w3, *sh_w2, *ln_ffn_g, *ln_ffn_b;
  float* out;
  float *rw5, *mod, *hf, *rw_r, *rw_w, *rw_k, *rw_v, *rw_kk, *rw_b, *rw_g, *rw_bonus, *rw_y;
  float *ckv, *qlat, *iws, *tmp, *xa, *xb, *logits, *gate, *slot_gate;
  int *idx, *eidx, *erank, *pos, *cnt, *offs, *tile_e, *ntm, *slot_tok;
  float* lacc;
  bf16_t *cMT, *cRP, *cNT, *cY1;
  bf16_t *loraA, *wb_w2, *wb_a2, *wb_g2, *wb_uk;
  bf16_t *ckvb, *h, *proj, *mixed, *ikn, *hid, *osort, *keys, *wb_in, *wb_out, *wb_up, *wb_dn;
};

__device__ __forceinline__ int otid() { int t = (int)__builtin_amdgcn_workitem_id_x(); asm volatile("" : "+v"(t)); return t; }
__device__ __forceinline__ float wave_sum(float v) {
#pragma unroll
  for (int o = 32; o > 0; o >>= 1) v += __shfl_xor(v, o);
  return v;
}
__device__ __forceinline__ float wave_max(float v) {
#pragma unroll
  for (int o = 32; o > 0; o >>= 1) v = fmaxf(v, __shfl_xor(v, o));
  return v;
}
__device__ __forceinline__ float sigmoidf_(float x) { return 1.0f / (1.0f + expf(-x)); }
__device__ __forceinline__ float siluf_(float x) { return x / (1.0f + expf(-x)); }
__device__ __forceinline__ float softplusf_(float x) { return fmaxf(x, 0.f) + log1pf(expf(-fabsf(x))); }
__device__ __forceinline__ bf16_t f2bf(float f) {
  unsigned u = __float_as_uint(f);
  u += 0x7fffu + ((u >> 16) & 1u);
  return (bf16_t)(u >> 16);
}
__device__ __forceinline__ float bf2f(bf16_t h) { return __uint_as_float(((unsigned)h) << 16); }
typedef float f32x2_t __attribute__((ext_vector_type(2)));
__device__ __forceinline__ unsigned pack2(float a, float b) { f32x2_t v = {a, b}; return __builtin_bit_cast(unsigned, __builtin_convertvector(v, bf16x2_t)); }

__device__ __forceinline__ void ph_mod(const P& p, int bid, int nb, char* smem) {
  float* cond = (float*)smem;
  for (int i = otid(); i < D; i += 256) cond[i] = siluf_(p.c[i]);
  __syncthreads();
  for (int i = bid * 256 + otid(); i < DEPTH * 6 * D; i += nb * 256) {
    int l = i / (6 * D), j = i % (6 * D);
    const float* w = p.w_mod + (size_t)l * D * 6 * D + j;
    float s = 0.f;
    for (int k = 0; k < D; ++k) s += cond[k] * w[(size_t)k * 6 * D];
    p.mod[i] = s + p.b_mod[i];
  }
}

__device__ __forceinline__ void ph_hmod(const P& p, const float* x, const float* sh, const float* sc, bf16_t* h, int bid, int nb) {
  for (size_t i = (size_t)bid * 256 + otid(); i < (size_t)L * D / 4; i += (size_t)nb * 256) {
    int c4 = (int)(i % (D / 4)) * 4;
    f32x4 v = *(const f32x4*)(x + i * 4);
    f32x4 s = *(const f32x4*)(sc + c4), b = *(const f32x4*)(sh + c4);
    f32x4 o = v * (s + 1.f) + b;
    uint2 pk; pk.x = pack2(o.x, o.y); pk.y = pack2(o.z, o.w);
    *(uint2*)(h + i * 4) = pk;
  }
  for (int i = bid * 256 + otid(); i < D; i += nb * 256) h[(size_t)L * D + i] = 0;
}

__device__ __forceinline__ void conv_tile(bf16_t* dst, int K, const float* src0, const float* src1, int ld, int mode, int nvalid, int nt, int kt, float (*t)[65], float scale = 1.0f) {
  const int tid = otid();
  const int n0 = nt * 64, k0 = kt * 64;
  __syncthreads();
  {
    const int n4 = (tid & 15) * 4, kb = tid >> 4;
    const float* src = src0; int col = n0 + n4; bool ok = true;
    if (mode == 0) ok = col < nvalid;
    else if (mode == 3) { const int n = n0 + n4; col = (n < 2116) ? n : (n - 4); ok = (n < 2116 || n >= 2120) && col < nvalid; }
    else { col = (n0 >> 6) * 32 + (n4 & 31); src = (n4 < 32) ? src0 : src1; }
#pragma unroll
    for (int i = 0; i < 4; ++i) {
      const int kk = kb + 16 * i;
      f32x4 v = (f32x4){0, 0, 0, 0};
      if (ok) v = *(const f32x4*)(src + (size_t)(k0 + kk) * ld + col);
      t[kk][n4] = v.x; t[kk][n4 + 1] = v.y; t[kk][n4 + 2] = v.z; t[kk][n4 + 3] = v.w;
    }
  }
  __syncthreads();
  {
    const int nn = tid >> 2, kq = (tid & 3) * 16;
    u32x4 o0, o1;
    o0.x = pack2(t[kq + 0][nn] * scale, t[kq + 1][nn] * scale); o0.y = pack2(t[kq + 2][nn] * scale, t[kq + 3][nn] * scale);
    o0.z = pack2(t[kq + 4][nn] * scale, t[kq + 5][nn] * scale); o0.w = pack2(t[kq + 6][nn] * scale, t[kq + 7][nn] * scale);
    o1.x = pack2(t[kq + 8][nn] * scale, t[kq + 9][nn] * scale); o1.y = pack2(t[kq + 10][nn] * scale, t[kq + 11][nn] * scale);
    o1.z = pack2(t[kq + 12][nn] * scale, t[kq + 13][nn] * scale); o1.w = pack2(t[kq + 14][nn] * scale, t[kq + 15][nn] * scale);
    bf16_t* d = dst + (size_t)(n0 + nn) * K + k0 + kq;
    *(u32x4*)d = o0; *(u32x4*)(d + 8) = o1;
  }
}
__device__ __forceinline__ void conv_out_tile(const P& p, int l, int nt, int kt, float (*t)[65]) {
  const int tid = otid();
  const int n0 = nt * 64, k0 = kt * 64;
  const float* wo = p.w_out + (size_t)l * D * D;
  __syncthreads();
  if (k0 < MX_DSA || k0 >= MX_SWA) {
    const int kr = (k0 < MX_DSA) ? k0 : (k0 - MX_SWA + 640);
    for (int i = tid; i < 4096; i += 256) { const int kk = i >> 6, nn = i & 63; t[kk][nn] = wo[(size_t)(kr + kk) * D + n0 + nn]; }
  } else {
    const int hd = (k0 - MX_DSA) / KVL, r0 = (k0 - MX_DSA) % KVL;
    const float* wuv = p.dsa_w_uv + ((size_t)l * 4 + hd) * KVL * 64;
    for (int i = tid; i < 4096; i += 256) {
      const int kk = i >> 6, nn = i & 63;
      float acc = 0.f;
      for (int e = 0; e < 64; ++e) acc += wuv[(size_t)(r0 + kk) * 64 + e] * wo[(size_t)(384 + hd * 64 + e) * D + n0 + nn];
      t[kk][nn] = acc;
    }
  }
  __syncthreads();
  for (int i = tid; i < 2048; i += 256) {
    const int nn = i >> 5, k2 = (i & 31) * 2;
    *(unsigned*)(p.wb_out + (size_t)(n0 + nn) * MXW + k0 + k2) = pack2(t[k2][nn], t[k2 + 1][nn]);
  }
}
__device__ __forceinline__ void ph_convert(const P& p, int l, int bid, int nb, char* smem) {
  float (*t)[65] = (float (*)[65])smem;
  constexpr int T_IN = (PINP / 64) * (D / 64), T_OUT = (D / 64) * (MXW / 64), T_UP = (512 / 64) * (D / 64), T_DN = (D / 64) * (DE / 64);
  constexpr int T_SM = 6 + 6 + 12 + 8;
  constexpr int TOT = T_IN + T_OUT + NEX * T_UP + NEX * T_DN + T_SM;
  for (int job = bid; job < TOT; job += nb) {
    int j = job;
    if (j < T_IN) { conv_tile(p.wb_in, D, p.w_in + (size_t)l * D * PIN, nullptr, PIN, 3, PIN, j / (D / 64), j % (D / 64), t); continue; }
    j -= T_IN;
    if (j < T_OUT) { conv_out_tile(p, l, j / (MXW / 64), j % (MXW / 64), t); continue; }
    j -= T_OUT;
    if (j < NEX * T_UP) {
      const int e = j / T_UP, r = j % T_UP;
      const float* s1 = (e < NE) ? p.exp_w1 + ((size_t)l * NE + e) * D * DE : p.sh_w1 + (size_t)l * D * DE;
      const float* s3 = (e < NE) ? p.exp_w3 + ((size_t)l * NE + e) * D * DE : p.sh_w3 + (size_t)l * D * DE;
      conv_tile(p.wb_up + (size_t)e * 512 * D, D, s1, s3, DE, 1, 0, r / (D / 64), r % (D / 64), t);
      continue;
    }
    j -= NEX * T_UP;
    if (j >= NEX * T_DN) {
      j -= NEX * T_DN;
      if (j < 6) conv_tile(p.wb_w2, 64, p.rwkv_w2 + (size_t)l * 64 * RW, nullptr, RW, 0, RW, j, 0, t);
      else if (j < 12) conv_tile(p.wb_a2, 64, p.rwkv_a2 + (size_t)l * 64 * RW, nullptr, RW, 0, RW, j - 6, 0, t);
      else if (j < 24) conv_tile(p.wb_g2, 128, p.rwkv_g2 + (size_t)l * 128 * RW, nullptr, RW, 0, RW, (j - 12) >> 1, (j - 12) & 1, t);
      else { const int hd = (j - 24) >> 1, nt = (j - 24) & 1; conv_tile(p.wb_uk + (size_t)hd * KVL * 64, 64, p.dsa_w_uk + ((size_t)l * 4 + hd) * 64 * KVL, nullptr, KVL, 0, KVL, nt, 0, t, 0.125f); }
      continue;
    }
    {
      const int e = j / T_DN, r = j % T_DN;
      const float* s2 = (e < NE) ? p.exp_w2 + ((size_t)l * NE + e) * DE * D : p.sh_w2 + (size_t)l * DE * D;
      conv_tile(p.wb_dn + (size_t)e * D * DE, DE, s2, nullptr, D, 0, D, r / (DE / 64), r % (DE / 64), t);
    }
  }
}

struct BG {
  const bf16_t* A; const int* rowidx; const bf16_t* Bt; const int* tile_e; const int* ntm_ptr;
  void* C; const float* rowscale;
  long bstride; int lda, K, ldc, ntm, ntn, pad;
};
__device__ __forceinline__ void glds16(const void* g, LDSP void* l) {
  __builtin_amdgcn_global_load_lds((const unsigned*)g, (LDSP unsigned*)l, 16, 0, 0);
}
template <int EPI>
__device__ __forceinline__ void ph_bgemm(const BG& g, int bid, int nb, char* smem) {
  LDSP char* lds = (LDSP char*)smem;
  const int tid = otid(), lane = tid & 63, w = tid >> 6, wr = w >> 1, wc = w & 1;
  const int fr = lane & 15, fq = lane >> 4;
  const int ntm = g.ntm_ptr ? *g.ntm_ptr : g.ntm;
  const int ntn = g.ntn, nk = g.K / 64;
  const int srow = tid >> 3, c16 = (tid & 7) ^ (srow & 7);
  const int x7 = fr & 7;
  for (int tile = bid; tile < ntm * ntn; tile += nb) {
    const int mt = tile / ntn, nt = tile % ntn;
    const int m0 = mt * 128, n0 = nt * 128;
    const bf16_t* Bt = g.Bt;
    if (g.tile_e) Bt += (long)g.tile_e[mt] * g.bstride;
    const bf16_t* ap[4]; const bf16_t* bp[4];
#pragma unroll
    for (int i = 0; i < 4; ++i) {
      int ar = m0 + i * 32 + srow;
      if (g.rowidx) ar = g.rowidx[ar];
      ap[i] = g.A + (size_t)ar * g.lda + c16 * 8;
      bp[i] = Bt + (size_t)(n0 + i * 32 + srow) * g.K + c16 * 8;
    }
    f32x4 acc[4][4];
#pragma unroll
    for (int i = 0; i < 4; ++i)
#pragma unroll
      for (int j = 0; j < 4; ++j) acc[i][j] = (f32x4){0, 0, 0, 0};
#pragma unroll
    for (int i = 0; i < 4; ++i) {
      glds16(ap[i], lds + (i * 256 + tid) * 16);
      glds16(bp[i], lds + 16384 + (i * 256 + tid) * 16);
    }
    asm volatile("s_waitcnt vmcnt(0)" ::: "memory");
    __syncthreads();
    for (int kt = 0; kt < nk; ++kt) {
      const int cur = kt & 1;
      if (kt + 1 < nk) {
        LDSP char* nb_ = lds + (cur ^ 1) * 32768;
#pragma unroll
        for (int i = 0; i < 4; ++i) {
          glds16(ap[i] + (kt + 1) * 64, nb_ + (i * 256 + tid) * 16);
          glds16(bp[i] + (kt + 1) * 64, nb_ + 16384 + (i * 256 + tid) * 16);
        }
      }
      LDSP char* la = lds + cur * 32768;
      LDSP char* lb = la + 16384;
#pragma unroll
      for (int ks = 0; ks < 2; ++ks) {
        bf16x8 af[4], bfv[4];
        const int sw = ((ks * 4 + fq) ^ x7) << 4;
#pragma unroll
        for (int i = 0; i < 4; ++i) {
          af[i] = *(LDSP const bf16x8*)(la + (wr * 64 + i * 16 + fr) * 128 + sw);
          bfv[i] = *(LDSP const bf16x8*)(lb + (wc * 64 + i * 16 + fr) * 128 + sw);
        }
#pragma unroll
        for (int i = 0; i < 4; ++i)
#pragma unroll
          for (int j = 0; j < 4; ++j) acc[i][j] = __builtin_amdgcn_mfma_f32_16x16x32_bf16(bfv[j], af[i], acc[i][j], 0, 0, 0);
      }
      asm volatile("s_waitcnt vmcnt(0)" ::: "memory");
      __syncthreads();
    }
#pragma unroll
    for (int i = 0; i < 4; ++i) {
      const int row = m0 + wr * 64 + i * 16 + fr;
      if (EPI == 0) {
        bf16_t* C = (bf16_t*)g.C;
#pragma unroll
        for (int j = 0; j < 4; ++j) {
          uint2 pk; pk.x = pack2(acc[i][j][0], acc[i][j][1]); pk.y = pack2(acc[i][j][2], acc[i][j][3]);
          *(uint2*)(C + (size_t)row * g.ldc + n0 + wc * 64 + j * 16 + fq * 4) = pk;
        }
      } else if (EPI == 1) {
        float* C = (float*)g.C;
#pragma unroll
        for (int j = 0; j < 4; ++j) *(f32x4*)(C + (size_t)row * g.ldc + n0 + wc * 64 + j * 16 + fq * 4) = acc[i][j];
      } else if (EPI == 2) {
        bf16_t* C = (bf16_t*)g.C;
#pragma unroll
        for (int j = 0; j < 2; ++j) {
          f32x4 a = acc[i][j], b = acc[i][j + 2];
          uint2 pk; pk.x = pack2(siluf_(a[0]) * b[0], siluf_(a[1]) * b[1]); pk.y = pack2(siluf_(a[2]) * b[2], siluf_(a[3]) * b[3]);
          *(uint2*)(C + (size_t)row * g.ldc + nt * 64 + wc * 32 + j * 16 + fq * 4) = pk;
        }
      } else {
        bf16_t* C = (bf16_t*)g.C;
        const float sc = g.rowscale[row];
#pragma unroll
        for (int j = 0; j < 4; ++j) {
          uint2 pk; pk.x = pack2(acc[i][j][0] * sc, acc[i][j][1] * sc); pk.y = pack2(acc[i][j][2] * sc, acc[i][j][3] * sc);
          *(uint2*)(C + (size_t)row * g.ldc + n0 + wc * 64 + j * 16 + fq * 4) = pk;
        }
      }
    }
  }
}

__device__ __forceinline__ void ph_router_gemm(const P& p, int l, int bid, int nb, char* smem) {
  float (*As)[80] = (float (*)[80])smem;
  float (*Bs)[80] = (float (*)[80])(smem + 16 * 80 * 4);
  const int tid = otid(), lane = tid & 63, w = tid >> 6, wm = w >> 1, wn = w & 1;
  const int lr = lane & 15, lq = lane >> 4;
  const float* B = p.router_w + (size_t)l * D * NE;
  for (int mt = bid; mt < L / 64; mt += nb) {
    const int m0 = mt * 64;
    f32x4 acc[2][2];
#pragma unroll
    for (int i = 0; i < 2; ++i)
#pragma unroll
      for (int j = 0; j < 2; ++j) acc[i][j] = (f32x4){0, 0, 0, 0};
    const int arow_l = tid >> 2, akq = (tid & 3) * 4;
    const int bk = tid >> 4, bn4 = (tid & 15) * 4;
    for (int k0 = 0; k0 < D; k0 += 16) {
      f32x4 av = *(const f32x4*)(p.hf + (size_t)(m0 + arow_l) * D + k0 + akq);
      f32x4 bv = *(const f32x4*)(B + (size_t)(k0 + bk) * NE + bn4);
      __syncthreads();
      As[akq + 0][arow_l] = av.x; As[akq + 1][arow_l] = av.y; As[akq + 2][arow_l] = av.z; As[akq + 3][arow_l] = av.w;
      *(f32x4*)&Bs[bk][bn4] = bv;
      __syncthreads();
#pragma unroll
      for (int kk = 0; kk < 4; ++kk) {
        float a[2], b[2];
#pragma unroll
        for (int i = 0; i < 2; ++i) a[i] = As[kk * 4 + lq][wm * 32 + i * 16 + lr];
#pragma unroll
        for (int j = 0; j < 2; ++j) b[j] = Bs[kk * 4 + lq][wn * 32 + j * 16 + lr];
#pragma unroll
        for (int i = 0; i < 2; ++i)
#pragma unroll
          for (int j = 0; j < 2; ++j) acc[i][j] = __builtin_amdgcn_mfma_f32_16x16x4f32(a[i], b[j], acc[i][j], 0, 0, 0);
      }
    }
#pragma unroll
    for (int i = 0; i < 2; ++i)
#pragma unroll
      for (int j = 0; j < 2; ++j)
#pragma unroll
        for (int r = 0; r < 4; ++r)
          p.logits[(size_t)(m0 + wm * 32 + i * 16 + lq * 4 + r) * NE + wn * 32 + j * 16 + lr] = acc[i][j][r];
  }
}

__device__ __forceinline__ float tshift(const bf16_t* cur, int t, int col, const float* mu) {
  const float cv = bf2f(cur[col]);
  const float pv = (t > 0) ? bf2f(cur[col - PINP]) : 0.f;
  return cv + (pv - cv) * mu[col];
}
__device__ __forceinline__ void ph_pre1(const P& p, int l, int bid, int nb) {
  const int tid = otid(), lane = tid & 63, w = tid >> 6;
  const float* mu = p.rwkv_mu + (size_t)l * NRWC;
  const float* kvn = p.dsa_kv_norm + (size_t)l * KVL;
  const float* ikg = p.dsa_ik_g + (size_t)l * 64; const float* ikb = p.dsa_ik_b + (size_t)l * 64;
  for (int t = bid * 4 + w; t < L; t += nb * 4) {
    const bf16_t* cur = p.proj + (size_t)t * PINP;
    bf16_t* lo = p.loraA + (size_t)t * 256;
    lo[lane] = f2bf(tanhf(tshift(cur, t, C_WL + lane, mu)));
    lo[64 + lane] = f2bf(tshift(cur, t, C_AL + lane, mu));
    lo[128 + lane] = f2bf(sigmoidf_(tshift(cur, t, C_GL + lane, mu)));
    lo[192 + lane] = f2bf(sigmoidf_(tshift(cur, t, C_GL + 64 + lane, mu)));
    {
      const float a = bf2f(cur[C_CKV + lane]), b = bf2f(cur[C_CKV + 64 + lane]);
      const float ms = wave_sum(a * a + b * b) * (1.f / 128.f);
      const float rs = rsqrtf(ms + 1e-6f);
      p.ckvb[(size_t)t * KVL + lane] = f2bf(a * rs * kvn[lane]);
      p.ckvb[(size_t)t * KVL + 64 + lane] = f2bf(b * rs * kvn[64 + lane]);
    }
    {
      const float a = bf2f(cur[C_IK + lane]);
      const float mean = wave_sum(a) * (1.f / 64.f);
      const float d = a - mean;
      const float var = wave_sum(d * d) * (1.f / 64.f);
      p.ikn[(size_t)t * 64 + lane] = f2bf(d * rsqrtf(var + LN_EPS) * ikg[lane] + ikb[lane]);
    }
    if (lane < 4) p.iws[(size_t)t * 4 + lane] = bf2f(cur[C_IW + lane]) * (1.f / 16.f);
  }
}

__device__ __forceinline__ void ph_pre3(const P& p, int l, int bid, int nb) {
  const int tid = otid(), lane = tid & 63, w = tid >> 6;
  const float* mu = p.rwkv_mu + (size_t)l * NRWC;
  const float* w0 = p.rwkv_w0 + (size_t)l * RW; const float* a0 = p.rwkv_a0 + (size_t)l * RW;
  const float* k_k = p.rwkv_k_k + (size_t)l * RW; const float* k_a = p.rwkv_k_a + (size_t)l * RW;
  const float* r_k = p.rwkv_r_k + (size_t)l * RW;
  for (int item = bid * 4 + w; item < L * 6; item += nb * 4) {
    const int t = item / 6, hd = item % 6, c = hd * 64 + lane;
    const bf16_t* cur = p.proj + (size_t)t * PINP;
    const float r = tshift(cur, t, C_R + c, mu), k = tshift(cur, t, C_K + c, mu), v = tshift(cur, t, C_V + c, mu);
    const float* la = p.lacc + (size_t)t * (3 * RW);
    const float wacc = la[c] + w0[c], aacc = la[RW + c] + a0[c], gacc = la[2 * RW + c];
    const float wl = -softplusf_(-wacc) - 0.5f;
    const float decay = expf(-expf(wl));
    const float a = sigmoidf_(aacc);
    const float kkv = k * k_k[c];
    const float nrm = sqrtf(wave_sum(kkv * kkv));
    const float kk = kkv / fmaxf(nrm, 1e-12f);
    const float k2 = k * (1.f + (a - 1.f) * k_a[c]);
    const float bon = wave_sum(r * k2 * r_k[c]);
    const size_t o = (size_t)t * RW + c;
    p.rw_r[o] = r; p.rw_w[o] = decay; p.rw_k[o] = k2; p.rw_v[o] = v; p.rw_kk[o] = kk; p.rw_b[o] = kk * a; p.rw_g[o] = gacc;
    if (lane == 0) p.rw_bonus[(size_t)t * 6 + hd] = bon;
  }
}

template <int CTRL> __device__ __forceinline__ float dpp_mov(float x) {
  return __int_as_float(__builtin_amdgcn_update_dpp(0, __float_as_int(x), CTRL, 0xf, 0xf, true));
}
__device__ __forceinline__ float red16(float v) {
  v += dpp_mov<0x128>(v); v += dpp_mov<0x124>(v); v += dpp_mov<0x122>(v); v += dpp_mov<0x121>(v);
  return v;
}
constexpr int SCH_T = 16;
constexpr int SC_BUF = SCH_T * 5 * 64 * 4;
__device__ __forceinline__ void scan_stage(const P& p, int c, int b, int hd, int vg, int tid, LDSP char* lds) {
#pragma unroll
  for (int i = 0; i < 5; ++i) {
    const int q = i * 256 + tid;
    const int step = q / 80, rem = q % 80, vec = rem >> 4, part = rem & 15;
    const float* g = p.rw5 + (size_t)vec * L * RW + (size_t)(c * SCH_T + step) * RW + hd * 64 + part * 4;
    glds16(g, lds + b * SC_BUF + q * 16);
  }
  if (tid < 64) {
    const int step = tid >> 2, part = tid & 3;
    glds16(p.rw_v + (size_t)(c * SCH_T + step) * RW + hd * 64 + vg * 16 + part * 4, lds + 2 * SC_BUF + b * 1024 + tid * 16);
  }
}
__device__ __forceinline__ void ph_rwkv_scan(const P& p, int item, char* smem) {
  LDSP char* lds = (LDSP char*)smem;
  const int tid = otid(), lane = tid & 63, w = tid >> 6;
  const int hd = item >> 2, vg = item & 3;
  const int rowl = w * 4 + (lane >> 4), kg = lane & 15;
  LDSP float* ybuf = (LDSP float*)(lds + 2 * SC_BUF + 2048);
  f32x4 S = (f32x4){0, 0, 0, 0};
  __builtin_amdgcn_s_setprio(3);
  __syncthreads();
  scan_stage(p, 0, 0, hd, vg, tid, lds);
  for (int c = 0; c < L / SCH_T; ++c) {
    const int b = c & 1;
    asm volatile("s_waitcnt vmcnt(0)" ::: "memory");
    __syncthreads();
    if (c + 1 < L / SCH_T) scan_stage(p, c + 1, b ^ 1, hd, vg, tid, lds);
    LDSP const char* in = lds + b * SC_BUF + kg * 16;
    LDSP const float* vb = (LDSP const float*)(lds + 2 * SC_BUF + b * 1024) + rowl;
    f32x4 kk = *(LDSP const f32x4*)(in), wv = *(LDSP const f32x4*)(in + 256), bv = *(LDSP const f32x4*)(in + 512);
    f32x4 kv = *(LDSP const f32x4*)(in + 768), rv = *(LDSP const f32x4*)(in + 1024);
    float v = vb[0];
#pragma unroll
    for (int st = 0; st < SCH_T; ++st) {
      f32x4 kk2, wv2, bv2, kv2, rv2; float v2;
      if (st + 1 < SCH_T) {
        LDSP const char* in2 = in + (st + 1) * 1280;
        kk2 = *(LDSP const f32x4*)(in2); wv2 = *(LDSP const f32x4*)(in2 + 256); bv2 = *(LDSP const f32x4*)(in2 + 512);
        kv2 = *(LDSP const f32x4*)(in2 + 768); rv2 = *(LDSP const f32x4*)(in2 + 1024); v2 = vb[(st + 1) * 16];
      }
      const f32x4 vk = kv * v;
      const f32x4 pk = S * kk;
      const float sa = -red16((pk.x + pk.y) + (pk.z + pk.w));
      S = S * wv + (bv * sa + vk);
      const f32x4 py = S * rv;
      const float y = red16((py.x + py.y) + (py.z + py.w));
      if (kg == 0) ybuf[st * 16 + rowl] = y;
      if (st + 1 < SCH_T) { kk = kk2; wv = wv2; bv = bv2; kv = kv2; rv = rv2; v = v2; }
    }
    __syncthreads();
    p.rw_y[(size_t)(c * SCH_T + (tid >> 4)) * RW + hd * 64 + vg * 16 + (tid & 15)] = ybuf[tid];
  }
  __builtin_amdgcn_s_setprio(0);
}

constexpr int CL = 64, NCH = L / CL;
constexpr int CH_ELEMS = 4096;
__device__ __forceinline__ int krow32(int s_, int h, int j) { return 16 * s_ + 8 * (j >> 2) + 4 * h + (j & 3); }
__device__ __forceinline__ void ph_rwkv_chunk(const P& p, int bid, int nb, char* smem) {
  LDSP char* lds = (LDSP char*)smem;
  constexpr int SUB = 8, SBUF = 2 * SUB * 1280, VBUF = 2 * SUB * 256, BUFSZ = SBUF + VBUF;
  for (int item = bid; item < NCH * 3; item += nb) {
    const int tid = otid(), lane = tid & 63, w = tid >> 6;
    const int hh = w >> 1;
    const bool isB = (w & 1) != 0;
    LDSP bf16_t* outRY = (LDSP bf16_t*)(lds + 2 * BUFSZ + w * 8192);
    const int c = item / 3, hp = item - c * 3;
    const int hd = 2 * hp + hh;
    auto stage = [&](int sc, int b) {
#pragma unroll
      for (int i = 0; i < 5; ++i) {
        const int q = i * 256 + tid, h2 = q / 640, rem = q - h2 * 640, step = rem / 80, r2 = rem - step * 80, vec = r2 >> 4, part = r2 & 15;
        glds16(p.rw5 + (size_t)vec * L * RW + (size_t)(c * CL + sc * SUB + step) * RW + (2 * hp + h2) * 64 + part * 4, lds + b * BUFSZ + q * 16);
      }
      {
        const int h2 = tid >> 7, step = (tid & 127) >> 4, part = tid & 15;
        glds16(p.rw_v + (size_t)(c * CL + sc * SUB + step) * RW + (2 * hp + h2) * 64 + part * 4, lds + b * BUFSZ + SBUF + tid * 16);
      }
    };
    f32x4 row[16];
#pragma unroll
    for (int i = 0; i < 16; ++i) row[i] = (f32x4){0, 0, 0, 0};
    if (!isB) {
#pragma unroll
      for (int i = 0; i < 16; ++i)
#pragma unroll
        for (int e = 0; e < 4; ++e) row[i][e] = (lane == i * 4 + e) ? 1.f : 0.f;
    }
    __syncthreads();
    stage(0, 0);
    for (int sc = 0; sc < CL / SUB; ++sc) {
      const int b = sc & 1;
      asm volatile("s_waitcnt vmcnt(0)" ::: "memory");
      __syncthreads();
      if (sc + 1 < CL / SUB) stage(sc + 1, b ^ 1);
      LDSP const char* in = lds + b * BUFSZ + hh * (SUB * 1280);
      LDSP const float* vb = (LDSP const float*)(lds + b * BUFSZ + SBUF + hh * (SUB * 256));
#pragma unroll 1
      for (int st = 0; st < SUB; ++st) {
        LDSP const f32x4* vkk = (LDSP const f32x4*)(in + st * 1280);
        const float vi = isB ? vb[st * 64 + lane] : 0.f;
        f32x4 d0 = (f32x4){0, 0, 0, 0}, d1 = (f32x4){0, 0, 0, 0};
#pragma unroll
        for (int i = 0; i < 16; i += 2) { const f32x4 ka = vkk[i], kb = vkk[i + 1]; d0 += row[i] * ka; d1 += row[i + 1] * kb; asm volatile("" ::: "memory"); }
        d0 += d1;
        const float sa = -((d0.x + d0.y) + (d0.z + d0.w));
        f32x4 y0 = (f32x4){0, 0, 0, 0}, y1 = (f32x4){0, 0, 0, 0};
#pragma unroll
        for (int i = 0; i < 16; ++i) {
          const f32x4 wv = vkk[16 + i], bv = vkk[32 + i], kv = vkk[48 + i], rv = vkk[64 + i];
          row[i] = row[i] * wv + (bv * sa + kv * vi);
          if (i & 1) y1 += row[i] * rv; else y0 += row[i] * rv;
          if ((i & 3) == 3) asm volatile("" ::: "memory");
        }
        y0 += y1;
        outRY[(sc * SUB + st) * 64 + lane] = f2bf((y0.x + y0.y) + (y0.z + y0.w));
      }
    }
    __syncthreads();
    const size_t ch = (size_t)(c * 6 + hd) * CH_ELEMS;
    if (!isB) {
      LDSP bf16_t* mb = (LDSP bf16_t*)(lds + hh * 8192);
#pragma unroll
      for (int i = 0; i < 16; ++i) { u32x2 pk; pk.x = pack2(row[i].x, row[i].y); pk.y = pack2(row[i].z, row[i].w); *(LDSP u32x2*)(mb + lane * 64 + i * 4) = pk; }
      const int r = lane & 31, h = lane >> 5;
#pragma unroll
      for (int f = 0; f < 8; ++f) {
        const int ktp = f >> 2, kt = (f >> 1) & 1, s_ = f & 1;
        unsigned short e[8];
#pragma unroll
        for (int j = 0; j < 8; ++j) e[j] = mb[(32 * kt + krow32(s_, h, j)) * 64 + 32 * ktp + r];
        u32x4 v; v.x = e[0] | ((unsigned)e[1] << 16); v.y = e[2] | ((unsigned)e[3] << 16); v.z = e[4] | ((unsigned)e[5] << 16); v.w = e[6] | ((unsigned)e[7] << 16);
        *(u32x4*)(p.cMT + ch + (f * 64 + lane) * 8) = v;
      }
#pragma unroll
      for (int f = 0; f < 8; ++f) {
        const int it = f >> 2, kt = (f >> 1) & 1, s_ = f & 1;
        const int i = 32 * it + r, k0 = 32 * kt + 16 * s_ + 4 * h;
        const u32x2 lo = *(LDSP const u32x2*)(outRY + i * 64 + k0), hi = *(LDSP const u32x2*)(outRY + i * 64 + k0 + 8);
        u32x4 v; v.x = lo.x; v.y = lo.y; v.z = hi.x; v.w = hi.y;
        *(u32x4*)(p.cRP + ch + (f * 64 + lane) * 8) = v;
      }
    } else {
      const int vw = lane >> 5, col = lane & 31;
#pragma unroll
      for (int ktp = 0; ktp < 2; ++ktp)
#pragma unroll
        for (int g = 0; g < 4; ++g)
#pragma unroll
          for (int h = 0; h < 2; ++h) {
            const f32x4 q = row[(32 * ktp + 8 * g + 4 * h) >> 2];
            uint2 pk; pk.x = pack2(q.x, q.y); pk.y = pack2(q.z, q.w);
            *(uint2*)(p.cNT + ch + ((((vw * 2 + ktp) * 4 + g) * 64 + h * 32 + col) * 4)) = pk;
          }
      const int h = lane >> 5;
#pragma unroll
      for (int vw2 = 0; vw2 < 2; ++vw2)
#pragma unroll
        for (int it = 0; it < 2; ++it)
#pragma unroll
          for (int g = 0; g < 4; ++g) {
            const int i0 = 32 * it + 8 * g + 4 * h, v = 32 * vw2 + col;
            const unsigned e0 = outRY[(i0 + 0) * 64 + v], e1 = outRY[(i0 + 1) * 64 + v], e2 = outRY[(i0 + 2) * 64 + v], e3 = outRY[(i0 + 3) * 64 + v];
            uint2 pk; pk.x = e0 | (e1 << 16); pk.y = e2 | (e3 << 16);
            *(uint2*)(p.cY1 + ch + ((((vw2 * 2 + it) * 4 + g) * 64 + lane) * 4)) = pk;
          }
    }
  }
}

typedef float f32x16 __attribute__((ext_vector_type(16)));
__device__ __forceinline__ void ph_rwkv_chain(const P& p, int hd, char* smem) {
  LDSP char* lds = (LDSP char*)smem;
  const int tid = otid(), lane = tid & 63, w = tid >> 6;
  const int col = lane & 31, h = lane >> 5;
  constexpr int CB = 4 * CH_ELEMS * 2;
  auto stage = [&](int c, int b) {
    const size_t ch = (size_t)(c * 6 + hd) * CH_ELEMS;
#pragma unroll
    for (int i = 0; i < 8; ++i) {
      const int q = i * 256 + tid, arr = q >> 9, off = q & 511;
      const bf16_t* src = p.cMT + (size_t)arr * ((size_t)NCH * 6 * CH_ELEMS) + ch + off * 8;
      glds16(src, lds + b * CB + q * 16);
    }
  };
  f32x16 X[2];
#pragma unroll
  for (int i = 0; i < 16; ++i) { X[0][i] = 0.f; X[1][i] = 0.f; }
  __builtin_amdgcn_s_setprio(3);
  __syncthreads();
  stage(0, 0);
  for (int c = 0; c < NCH; ++c) {
    const int b = c & 1;
    asm volatile("s_waitcnt vmcnt(0)" ::: "memory");
    __syncthreads();
    if (c + 1 < NCH) stage(c + 1, b ^ 1);
    if (w < 2) {
      const int vw = w;
      LDSP const char* base = lds + b * CB;
      bf16x8 xs[2][2];
#pragma unroll
      for (int kt = 0; kt < 2; ++kt)
#pragma unroll
        for (int s_ = 0; s_ < 2; ++s_) {
          u32x4 v;
          v.x = pack2(X[kt][8 * s_ + 0], X[kt][8 * s_ + 1]); v.y = pack2(X[kt][8 * s_ + 2], X[kt][8 * s_ + 3]);
          v.z = pack2(X[kt][8 * s_ + 4], X[kt][8 * s_ + 5]); v.w = pack2(X[kt][8 * s_ + 6], X[kt][8 * s_ + 7]);
          xs[kt][s_] = __builtin_bit_cast(bf16x8, v);
        }
#pragma unroll
      for (int it = 0; it < 2; ++it) {
        f32x16 acc;
#pragma unroll
        for (int g = 0; g < 4; ++g) {
          const u32x2 q = *(LDSP const u32x2*)(base + 3 * 8192 + ((((vw * 2 + it) * 4 + g) * 64 + lane) * 8));
          acc[4 * g + 0] = __uint_as_float(q.x << 16); acc[4 * g + 1] = __uint_as_float(q.x & 0xffff0000u);
          acc[4 * g + 2] = __uint_as_float(q.y << 16); acc[4 * g + 3] = __uint_as_float(q.y & 0xffff0000u);
        }
#pragma unroll
        for (int kt = 0; kt < 2; ++kt)
#pragma unroll
          for (int s_ = 0; s_ < 2; ++s_) {
            const bf16x8 a = *(LDSP const bf16x8*)(base + 8192 + ((((it * 2 + kt) * 2 + s_) * 64 + lane) * 16));
            acc = __builtin_amdgcn_mfma_f32_32x32x16_bf16(a, xs[kt][s_], acc, 0, 0, 0);
          }
#pragma unroll
        for (int i = 0; i < 16; ++i) {
          const int t = c * CL + 32 * it + (i & 3) + 8 * (i >> 2) + 4 * h;
          p.rw_y[(size_t)t * RW + hd * 64 + 32 * vw + col] = acc[i];
        }
      }
      f32x16 Xn[2];
#pragma unroll
      for (int ktp = 0; ktp < 2; ++ktp) {
#pragma unroll
        for (int g = 0; g < 4; ++g) {
          const u32x2 q = *(LDSP const u32x2*)(base + 2 * 8192 + ((((vw * 2 + ktp) * 4 + g) * 64 + lane) * 8));
          Xn[ktp][4 * g + 0] = __uint_as_float(q.x << 16); Xn[ktp][4 * g + 1] = __uint_as_float(q.x & 0xffff0000u);
          Xn[ktp][4 * g + 2] = __uint_as_float(q.y << 16); Xn[ktp][4 * g + 3] = __uint_as_float(q.y & 0xffff0000u);
        }
#pragma unroll
        for (int kt = 0; kt < 2; ++kt)
#pragma unroll
          for (int s_ = 0; s_ < 2; ++s_) {
            const bf16x8 a = *(LDSP const bf16x8*)(base + ((((ktp * 2 + kt) * 2 + s_) * 64 + lane) * 16));
            Xn[ktp] = __builtin_amdgcn_mfma_f32_32x32x16_bf16(a, xs[kt][s_], Xn[ktp], 0, 0, 0);
          }
      }
      X[0] = Xn[0]; X[1] = Xn[1];
    }
  }
  __builtin_amdgcn_s_setprio(0);
}

__device__ __forceinline__ void ph_rwkv_post(const P& p, int l, int bid, int nb) {
  const int tid = otid(), lane = tid & 63, w = tid >> 6;
  const float* lg = p.rwkv_ln_g + (size_t)l * RW; const float* lb = p.rwkv_ln_b + (size_t)l * RW;
  for (int item = bid * 4 + w; item < L * 6; item += nb * 4) {
    const int t = item / 6, hd = item % 6, c = hd * 64 + lane;
    size_t o = (size_t)t * RW + c;
    float y = p.rw_y[o];
    float mean = wave_sum(y) * (1.f / 64.f);
    float d = y - mean;
    float var = wave_sum(d * d) * (1.f / 64.f);
    float on = d * rsqrtf(var + GN_EPS) * lg[c] + lb[c];
    float res = (on + p.rw_bonus[(size_t)t * 6 + hd] * p.rw_v[o]) * p.rw_g[o];
    p.mixed[(size_t)t * MXW + c] = f2bf(res);
  }
}

__device__ __forceinline__ size_t keys_rowoff(int t) {
  const int qt = t >> 7;
  return (size_t)qt * (qt + 1) / 2 * (128 * 128) + (size_t)(t & 127) * (qt + 1) * 128;
}
__device__ __forceinline__ unsigned okey16(float f) {
  unsigned u = __float_as_uint(f);
  u = (u & 0x80000000u) ? ~u : (u | 0x80000000u);
  return u >> 16;
}
__device__ __forceinline__ void ph_idx_scores(const P& p, int bid, int nb, char* smem) {
  LDSP char* lds = (LDSP char*)smem;
  const int tid = otid(), lane = tid & 63, w = tid >> 6, wr = w >> 1, wc = w & 1;
  const int fr = lane & 15, fq = lane >> 4;
  const int srow = tid >> 3, c16 = (tid & 7) ^ (srow & 7);
  const int x7 = fr & 7;
  constexpr int NCH = (NQT + KCH - 1) / KCH;
  for (int unit = bid; unit < NQT * NCH; unit += nb) {
    const int qt = unit / NCH, ch = unit % NCH;
    if (ch * KCH > qt) continue;
    const int q0 = qt * 128;
    __syncthreads();
#pragma unroll
    for (int hd = 0; hd < 4; ++hd)
#pragma unroll
      for (int i = 0; i < 4; ++i)
        glds16(p.proj + (size_t)(q0 + i * 32 + srow) * PINP + C_IQ + hd * 64 + c16 * 8, lds + hd * 16384 + (i * 256 + tid) * 16);
    const int kt_end = min(qt + 1, (ch + 1) * KCH);
    for (int kt = ch * KCH; kt < kt_end; ++kt) {
      const int s0 = kt * 128;
      __syncthreads();
#pragma unroll
      for (int i = 0; i < 4; ++i) glds16(p.ikn + (size_t)(s0 + i * 32 + srow) * 64 + c16 * 8, lds + 65536 + (i * 256 + tid) * 16);
      asm volatile("s_waitcnt vmcnt(0)" ::: "memory");
      __syncthreads();
#pragma unroll 1
      for (int jh = 0; jh < 2; ++jh) {
        f32x4 sc[4][2];
#pragma unroll
        for (int i = 0; i < 4; ++i)
#pragma unroll
          for (int j = 0; j < 2; ++j) sc[i][j] = (f32x4){0, 0, 0, 0};
#pragma unroll 1
        for (int hd = 0; hd < 4; ++hd) {
          f32x4 acc[4][2];
#pragma unroll
          for (int i = 0; i < 4; ++i)
#pragma unroll
            for (int j = 0; j < 2; ++j) acc[i][j] = (f32x4){0, 0, 0, 0};
#pragma unroll
          for (int ks = 0; ks < 2; ++ks) {
            bf16x8 af[4], bfv[2];
            const int sw = ((ks * 4 + fq) ^ x7) << 4;
#pragma unroll
            for (int i = 0; i < 4; ++i) af[i] = *(LDSP const bf16x8*)(lds + hd * 16384 + (wr * 64 + i * 16 + fr) * 128 + sw);
#pragma unroll
            for (int j = 0; j < 2; ++j) bfv[j] = *(LDSP const bf16x8*)(lds + 65536 + (wc * 64 + (jh * 2 + j) * 16 + fr) * 128 + sw);
#pragma unroll
            for (int i = 0; i < 4; ++i)
#pragma unroll
              for (int j = 0; j < 2; ++j) acc[i][j] = __builtin_amdgcn_mfma_f32_16x16x32_bf16(bfv[j], af[i], acc[i][j], 0, 0, 0);
          }
#pragma unroll
          for (int i = 0; i < 4; ++i) {
            const float wg = p.iws[(size_t)(q0 + wr * 64 + i * 16 + fr) * 4 + hd];
#pragma unroll
            for (int j = 0; j < 2; ++j) {
              sc[i][j][0] += fmaxf(acc[i][j][0], 0.f) * wg; sc[i][j][1] += fmaxf(acc[i][j][1], 0.f) * wg;
              sc[i][j][2] += fmaxf(acc[i][j][2], 0.f) * wg; sc[i][j][3] += fmaxf(acc[i][j][3], 0.f) * wg;
            }
          }
        }
#pragma unroll
        for (int i = 0; i < 4; ++i) {
          const int q = q0 + wr * 64 + i * 16 + fr;
          bf16_t* kr = p.keys + keys_rowoff(q) + s0 + wc * 64 + jh * 32 + fq * 4;
#pragma unroll
          for (int j = 0; j < 2; ++j) {
            uint2 pk;
            pk.x = okey16(sc[i][j][0]) | (okey16(sc[i][j][1]) << 16);
            pk.y = okey16(sc[i][j][2]) | (okey16(sc[i][j][3]) << 16);
            *(uint2*)(kr + j * 16) = pk;
          }
        }
      }
    }
  }
}

__device__ __forceinline__ unsigned block_excl_scan(unsigned v, volatile unsigned* tot4, int lane, int w) {
  unsigned x = v;
#pragma unroll
  for (int o = 1; o < 64; o <<= 1) { const unsigned y = __shfl_up(x, o); if (lane >= o) x += y; }
  __syncthreads();
  if (lane == 63) tot4[w] = x;
  __syncthreads();
  unsigned base = 0;
#pragma unroll
  for (int i = 0; i < 3; ++i) base += (i < w) ? tot4[i] : 0u;
  return base + x - v;
}
__device__ __forceinline__ void ph_topk(const P& p, int bid, int nb, char* smem) {
  bf16_t* keys = (bf16_t*)smem;
  unsigned* hist = (unsigned*)(smem + 36864);
  unsigned* hist2 = hist + 2048;
  unsigned* misc = hist2 + 32;
  unsigned* tot4 = misc + 8;
  const int tid = otid(), lane = tid & 63, w = tid >> 6;
  u32x4 g0, g1, g2, g3, g4, g5, g6, g7;
#define TOPK_FETCH(tt) do { const int t_ = (tt); const int n8_ = (t_ + 8) >> 3; const bf16_t* kr_ = p.keys + keys_rowoff(t_); \
    if (t_ + 1 > TOPK) { \
      if (tid < n8_) g0 = *(const u32x4*)(kr_ + (tid) * 8); if (tid + 256 < n8_) g1 = *(const u32x4*)(kr_ + (tid + 256) * 8); \
      if (tid + 512 < n8_) g2 = *(const u32x4*)(kr_ + (tid + 512) * 8); if (tid + 768 < n8_) g3 = *(const u32x4*)(kr_ + (tid + 768) * 8); \
      if (tid + 1024 < n8_) g4 = *(const u32x4*)(kr_ + (tid + 1024) * 8); if (tid + 1280 < n8_) g5 = *(const u32x4*)(kr_ + (tid + 1280) * 8); \
      if (tid + 1536 < n8_) g6 = *(const u32x4*)(kr_ + (tid + 1536) * 8); if (tid + 1792 < n8_) g7 = *(const u32x4*)(kr_ + (tid + 1792) * 8); } } while (0)
  g0 = g1 = g2 = g3 = g4 = g5 = g6 = g7 = (u32x4){0, 0, 0, 0};
  if (bid < L) TOPK_FETCH(bid);
  for (int t = bid; t < L; t += nb) {
    const int n = t + 1;
    int* out = p.idx + (size_t)t * TOPK;
    if (n <= TOPK) { out[tid] = (tid < n) ? tid : 0; if (t + nb < L) TOPK_FETCH(t + nb); continue; }
    const int lp = (n <= 4096) ? 4 : (n <= 8192) ? 5 : 6;
    const int per = 1 << lp;
    __syncthreads();
    {
      const int n8 = (n + 7) >> 3;
#define TOPK_PUT(j, gg) do { const int i_ = tid + 256 * (j); if (i_ < n8) { const int e_ = i_ * 8; *(u32x4*)(keys + e_ + 8 * (e_ >> lp)) = gg; } } while (0)
      TOPK_PUT(0, g0); TOPK_PUT(1, g1); TOPK_PUT(2, g2); TOPK_PUT(3, g3); TOPK_PUT(4, g4); TOPK_PUT(5, g5); TOPK_PUT(6, g6); TOPK_PUT(7, g7);
    }
    __syncthreads();
    if (t + nb < L) TOPK_FETCH(t + nb);
    const int i0 = tid << lp;
    const int cntk = max(0, min(per, n - i0));
    u32x4 kq[8];
    {
      const bf16_t* kc = keys + i0 + 8 * tid;
#pragma unroll
      for (int j = 0; j < 8; ++j) kq[j] = (j * 8 < per) ? *(const u32x4*)(kc + j * 8) : (u32x4){0, 0, 0, 0};
    }
    if (cntk < per) {
#pragma unroll
      for (int j = 0; j < 8; ++j)
#pragma unroll
        for (int d = 0; d < 4; ++d) {
          const int e0 = j * 8 + d * 2;
          const unsigned m = (e0 + 1 < cntk) ? 0xffffffffu : (e0 < cntk) ? 0x0000ffffu : 0u;
          kq[j][d] &= m;
        }
    }
#pragma unroll
    for (int j = 0; j < 8; ++j) hist[tid + 256 * j] = 0;
    if (tid < 32) hist2[tid] = 0;
    __syncthreads();
#pragma unroll
    for (int d = 0; d < 4; ++d) { const unsigned v = kq[0][d]; atomicAdd(&hist[(v >> 5) & 2047u], 1u); atomicAdd(&hist[v >> 21], 1u); }
    __syncthreads();
    unsigned pbA;
    {
      const u32x4 ha = *(const u32x4*)(hist + 2040 - 8 * tid), hb4 = *(const u32x4*)(hist + 2044 - 8 * tid);
      const unsigned hbv[8] = {hb4.w, hb4.z, hb4.y, hb4.x, ha.w, ha.z, ha.y, ha.x};
      unsigned tsum = 0;
#pragma unroll
      for (int q = 0; q < 8; ++q) tsum += hbv[q];
      unsigned above = block_excl_scan(tsum, tot4, lane, w);
      if ((int)above < TOPK && TOPK <= (int)(above + tsum)) {
        unsigned bsel = 0; bool found = false;
#pragma unroll
        for (int q = 0; q < 8; ++q) {
          if (!found && TOPK <= (int)(above + hbv[q])) { bsel = (unsigned)(2047 - 8 * tid - q); found = true; }
          if (!found) above += hbv[q];
        }
        misc[4] = bsel;
      }
      __syncthreads();
      pbA = misc[4];
    }
#pragma unroll
    for (int j = 0; j < 8; ++j) hist[tid + 256 * j] = 0;
    __syncthreads();
#pragma unroll
    for (int j = 0; j < 8; ++j) {
      if (j * 8 < per) {
#pragma unroll
        for (int d = 0; d < 4; ++d) {
          const unsigned v = kq[j][d];
          const unsigned b0 = (v >> 5) & 2047u, b1 = v >> 21;
          if (b0 >= pbA) atomicAdd(&hist[b0], 1u);
          if (b1 >= pbA) atomicAdd(&hist[b1], 1u);
        }
      }
    }
    __syncthreads();
    int need = TOPK; unsigned pb;
    {
      unsigned hb[8]; unsigned tsum = 0;
#pragma unroll
      for (int q = 0; q < 8; ++q) { hb[q] = hist[2047 - 8 * tid - q]; tsum += hb[q]; }
      unsigned above = block_excl_scan(tsum, tot4, lane, w);
      if ((int)above < need && need <= (int)(above + tsum)) {
        unsigned bsel = 0, nrem = 0; bool found = false;
#pragma unroll
        for (int q = 0; q < 8; ++q) {
          if (!found && need <= (int)(above + hb[q])) { bsel = (unsigned)(2047 - 8 * tid - q); nrem = (unsigned)(need - (int)above); found = true; }
          if (!found) above += hb[q];
        }
        misc[0] = bsel; misc[1] = nrem;
      }
      __syncthreads();
      pb = misc[0]; need = (int)misc[1];
    }
#pragma unroll
    for (int j = 0; j < 8; ++j) {
      if (j * 8 < per) {
#pragma unroll
        for (int d = 0; d < 4; ++d) {
          const unsigned v = kq[j][d];
          if (((v >> 5) & 2047u) == pb) atomicAdd(&hist2[v & 31u], 1u);
          if ((v >> 21) == pb) atomicAdd(&hist2[(v >> 16) & 31u], 1u);
        }
      }
    }
    __syncthreads();
    unsigned prefix;
    {
      const unsigned hb = (tid < 32) ? hist2[31 - tid] : 0u;
      const unsigned above = block_excl_scan(hb, tot4, lane, w);
      if (tid < 32 && (int)above < need && need <= (int)(above + hb)) { misc[2] = (unsigned)(31 - tid); misc[3] = (unsigned)(need - (int)above); }
      __syncthreads();
      prefix = (pb << 5) | misc[2]; need = (int)misc[3];
    }
    const int ngt = TOPK - need;
    int ceq = 0, cgt = 0;
#pragma unroll
    for (int j = 0; j < 8; ++j) {
      if (j * 8 < per) {
#pragma unroll
        for (int d = 0; d < 4; ++d) {
          const unsigned v = kq[j][d], lo = v & 0xffffu, hi = v >> 16;
          ceq += (lo == prefix) + (hi == prefix); cgt += (lo > prefix) + (hi > prefix);
        }
      }
    }
    const unsigned pk = block_excl_scan((unsigned)ceq | ((unsigned)cgt << 16), tot4, lane, w);
    int erank = (int)(pk & 0xffffu), grank = (int)(pk >> 16);
    if (ceq + cgt > 0) {
#pragma unroll
      for (int j = 0; j < 8; ++j)
#pragma unroll
        for (int e = 0; e < 8; ++e) {
          const unsigned k = (kq[j][e >> 1] >> ((e & 1) * 16)) & 0xffffu;
          if (k > prefix) { out[grank] = i0 + j * 8 + e; ++grank; }
          else if (k == prefix) { if (erank < need) out[ngt + erank] = i0 + j * 8 + e; ++erank; }
        }
    }
  }
}

__device__ __forceinline__ float dot2bf(unsigned a, unsigned b, float c) {
  return __builtin_amdgcn_fdot2_f32_bf16(__builtin_bit_cast(bf16x2_t, a), __builtin_bit_cast(bf16x2_t, b), c, false);
}
__device__ __forceinline__ void ph_dsa_attn(const P& p, int l, int bid, int nb, char* smem) {
  const int tid = otid(), lane = tid & 63, w = tid >> 6;
  LDSP char* wl = (LDSP char*)smem + w * 8192;
  LDSP unsigned* ql2 = (LDSP unsigned*)wl;
  LDSP f32x4* pl = (LDSP f32x4*)(wl + 1024);
  for (int t = bid * 4 + w; t < L; t += nb * 4) {
    const int cnt = min(TOPK, t + 1);
    {
      const f32x4 a = *(const f32x4*)(p.qlat + (size_t)t * 512 + lane * 4);
      const f32x4 b = *(const f32x4*)(p.qlat + (size_t)t * 512 + 256 + lane * 4);
      ql2[lane * 2] = pack2(a.x, a.y); ql2[lane * 2 + 1] = pack2(a.z, a.w);
      ql2[128 + lane * 2] = pack2(b.x, b.y); ql2[128 + lane * 2 + 1] = pack2(b.z, b.w);
    }
    int id[4];
#pragma unroll
    for (int i = 0; i < 4; ++i) id[i] = (lane + 64 * i < cnt) ? p.idx[(size_t)t * TOPK + lane + 64 * i] : 0;
    float lg[4][4];
#pragma unroll
    for (int i = 0; i < 4; ++i)
#pragma unroll
      for (int hd = 0; hd < 4; ++hd) lg[i][hd] = 0.f;
#pragma unroll 4
    for (int c = 0; c < 16; ++c) {
      u32x4 kv[4];
#pragma unroll
      for (int i = 0; i < 4; ++i) kv[i] = *(const u32x4*)(p.ckvb + (size_t)id[i] * KVL + c * 8);
#pragma unroll
      for (int hd = 0; hd < 4; ++hd) {
        const u32x4 q = *(LDSP const u32x4*)(ql2 + hd * 64 + c * 4);
#pragma unroll
        for (int i = 0; i < 4; ++i) {
          float a = lg[i][hd];
          a = dot2bf(kv[i].x, q.x, a); a = dot2bf(kv[i].y, q.y, a); a = dot2bf(kv[i].z, q.z, a); a = dot2bf(kv[i].w, q.w, a);
          lg[i][hd] = a;
        }
      }
    }
    float mx[4], sm[4];
#pragma unroll
    for (int hd = 0; hd < 4; ++hd) {
      const float slope = exp2f(-8.0f * (float)(6 + hd + 1) / 10.0f);
      float m = -INFINITY;
#pragma unroll
      for (int i = 0; i < 4; ++i) {
        const bool valid = (lane + 64 * i) < cnt;
        lg[i][hd] = valid ? (lg[i][hd] - slope * (float)(t - id[i])) : -INFINITY;
        m = fmaxf(m, lg[i][hd]);
      }
      mx[hd] = wave_max(m);
      float sacc = 0.f;
#pragma unroll
      for (int i = 0; i < 4; ++i) { lg[i][hd] = expf(lg[i][hd] - mx[hd]); sacc += lg[i][hd]; }
      sm[hd] = 1.f / wave_sum(sacc);
    }
#pragma unroll
    for (int i = 0; i < 4; ++i) pl[lane + 64 * i] = (f32x4){lg[i][0] * sm[0], lg[i][1] * sm[1], lg[i][2] * sm[2], lg[i][3] * sm[3]};
    float o[4][2];
#pragma unroll
    for (int hd = 0; hd < 4; ++hd) { o[hd][0] = 0.f; o[hd][1] = 0.f; }
#pragma unroll 1
    for (int i = 0; i < 4; ++i) {
      const int kend = min(64, cnt - 64 * i);
      const int idv = id[i];
#pragma unroll 1
      for (int k0 = 0; k0 < kend; k0 += 32) {
        unsigned cv[32];
#pragma unroll
        for (int kk = 0; kk < 32; ++kk) {
          const int kid = __builtin_amdgcn_readlane(idv, (k0 + kk) & 63);
          cv[kk] = *(const unsigned*)(p.ckvb + (size_t)kid * KVL + lane * 2);
        }
#pragma unroll
        for (int kk = 0; kk < 32; ++kk) {
          const f32x4 pv = pl[64 * i + k0 + kk];
          const float c0 = __uint_as_float(cv[kk] << 16), c1 = __uint_as_float(cv[kk] & 0xffff0000u);
          o[0][0] += pv.x * c0; o[0][1] += pv.x * c1; o[1][0] += pv.y * c0; o[1][1] += pv.y * c1;
          o[2][0] += pv.z * c0; o[2][1] += pv.z * c1; o[3][0] += pv.w * c0; o[3][1] += pv.w * c1;
        }
      }
    }
#pragma unroll
    for (int hd = 0; hd < 4; ++hd)
      *(unsigned*)(p.mixed + (size_t)t * MXW + MX_DSA + hd * KVL + lane * 2) = pack2(o[hd][0], o[hd][1]);
  }
}

__device__ __forceinline__ float rmax16(float v) {
  v = fmaxf(v, dpp_mov<0x128>(v)); v = fmaxf(v, dpp_mov<0x124>(v)); v = fmaxf(v, dpp_mov<0x122>(v)); v = fmaxf(v, dpp_mov<0x121>(v));
  return v;
}
constexpr int SW_VTROW = 432, SW_PROW = 336;
__device__ __forceinline__ void ph_swa(const P& p, int l, int bid, int nb, char* smem) {
  LDSP char* lds = (LDSP char*)smem;
  const int tid = otid(), lane = tid & 63, w = tid >> 6, fr = lane & 15, fq = lane >> 4;
  LDSP char* Ks = lds;
  LDSP char* VT = lds + 24576;
  LDSP char* Pw = lds + 24576 + 64 * SW_VTROW + w * (16 * SW_PROW);
  const float* sinks = p.swa_sinks + (size_t)l * 6;
  for (int item = bid; item < (L / 64) * 2; item += nb) {
    const int qt = item >> 1, g = item & 1, t0 = qt * 64, kb0 = t0 - 128;
    __syncthreads();
#pragma unroll
    for (int i = 0; i < 6; ++i) {
      const int q = i * 256 + tid, row = q >> 3, c16 = (q & 7) ^ (row & 7);
      const int sr = max(kb0 + row, 0);
      glds16(p.proj + (size_t)sr * PINP + C_SK + g * 64 + c16 * 8, Ks + q * 16);
    }
#pragma unroll
    for (int i = 0; i < 6; ++i) {
      const int q = i * 256 + tid, c = q / 192, row = q - c * 192;
      const int sr = max(kb0 + row, 0);
      const u32x4 v = *(const u32x4*)(p.proj + (size_t)sr * PINP + C_SV + g * 64 + c * 8);
      LDSP bf16_t* d = (LDSP bf16_t*)(VT + (c * 8) * SW_VTROW + row * 2);
      d[0 * (SW_VTROW / 2)] = (bf16_t)(v.x & 0xffffu); d[1 * (SW_VTROW / 2)] = (bf16_t)(v.x >> 16);
      d[2 * (SW_VTROW / 2)] = (bf16_t)(v.y & 0xffffu); d[3 * (SW_VTROW / 2)] = (bf16_t)(v.y >> 16);
      d[4 * (SW_VTROW / 2)] = (bf16_t)(v.z & 0xffffu); d[5 * (SW_VTROW / 2)] = (bf16_t)(v.z >> 16);
      d[6 * (SW_VTROW / 2)] = (bf16_t)(v.w & 0xffffu); d[7 * (SW_VTROW / 2)] = (bf16_t)(v.w >> 16);
    }
    for (int i = tid; i < 64 * 12; i += 256) *(LDSP unsigned*)(VT + (i / 12) * SW_VTROW + 384 + (i % 12) * 4) = 0u;
    for (int i = lane; i < 16 * 12; i += 64) *(LDSP unsigned*)(Pw + (i / 12) * SW_PROW + 288 + (i % 12) * 4) = 0u;
    asm volatile("s_waitcnt vmcnt(0)" ::: "memory");
    __syncthreads();
    const int tq = t0 + 16 * w;
#pragma unroll 1
    for (int hh = 0; hh < 3; ++hh) {
      const int hq = g * 3 + hh;
      const float slope = exp2f(-8.0f * (float)(hq + 1) / 10.0f);
      const float sink = sinks[hq];
      bf16x8 qf[2];
#pragma unroll
      for (int ks = 0; ks < 2; ++ks) qf[ks] = *(const bf16x8*)(p.proj + (size_t)(tq + fr) * PINP + C_SQ + hq * 64 + ks * 32 + fq * 8);
      float lg[9][4];
      float mx[4] = {-INFINITY, -INFINITY, -INFINITY, -INFINITY};
#pragma unroll
      for (int j = 0; j < 9; ++j) {
        const int krow = 16 * w + 16 * j + fr;
        f32x4 acc = (f32x4){0, 0, 0, 0};
#pragma unroll
        for (int ks = 0; ks < 2; ++ks) {
          const bf16x8 kf = *(LDSP const bf16x8*)(Ks + krow * 128 + (((ks * 4 + fq) ^ (krow & 7)) << 4));
          acc = __builtin_amdgcn_mfma_f32_16x16x32_bf16(qf[ks], kf, acc, 0, 0, 0);
        }
        const int sk = kb0 + krow;
#pragma unroll
        for (int r = 0; r < 4; ++r) {
          const int dist = 128 - 16 * j + fq * 4 + r - fr;
          const bool valid = (dist >= 0) && (dist < 128) && (sk >= 0);
          const float v = valid ? (acc[r] * 0.125f - slope * (float)dist) : -INFINITY;
          lg[j][r] = v; mx[r] = fmaxf(mx[r], v);
        }
      }
      float inv[4];
#pragma unroll
      for (int r = 0; r < 4; ++r) {
        const float m = fmaxf(rmax16(mx[r]), sink);
        float sacc = 0.f;
#pragma unroll
        for (int j = 0; j < 9; ++j) { lg[j][r] = expf(lg[j][r] - m); sacc += lg[j][r]; }
        inv[r] = 1.f / (red16(sacc) + expf(sink - m));
      }
#pragma unroll
      for (int j = 0; j < 9; ++j)
#pragma unroll
        for (int r = 0; r < 4; ++r) *(LDSP bf16_t*)(Pw + (fq * 4 + r) * SW_PROW + (16 * j + fr) * 2) = f2bf(lg[j][r] * inv[r]);
#pragma unroll
      for (int nt = 0; nt < 4; ++nt) {
        f32x4 acc = (f32x4){0, 0, 0, 0};
#pragma unroll
        for (int ks = 0; ks < 5; ++ks) {
          const bf16x8 vf = *(LDSP const bf16x8*)(VT + (nt * 16 + fr) * SW_VTROW + (16 * w + ks * 32 + fq * 8) * 2);
          const bf16x8 pf = *(LDSP const bf16x8*)(Pw + fr * SW_PROW + (ks * 32 + fq * 8) * 2);
          acc = __builtin_amdgcn_mfma_f32_16x16x32_bf16(vf, pf, acc, 0, 0, 0);
        }
        uint2 pk; pk.x = pack2(acc[0], acc[1]); pk.y = pack2(acc[2], acc[3]);
        *(uint2*)(p.mixed + (size_t)(tq + fr) * MXW + MX_SWA + hq * 64 + nt * 16 + fq * 4) = pk;
      }
    }
  }
}

template <bool COMBINE>
__device__ __forceinline__ void ph_ln(const P& p, const float* xin, const float* gatev, const float* lng, const float* lnb,
                      float* xout, const float* nsh, const float* nsc, bf16_t* hout, float* hfout, int bid, int nb, char* smem) {
  const int tid = otid(), lane = tid & 63, w = tid >> 6;
  for (int t = bid * 4 + w; t < L; t += nb * 4) {
    f32x4 v[4];
    int slot[TOPE + 1];
    if (COMBINE) {
#pragma unroll
      for (int k = 0; k < TOPE; ++k) slot[k] = p.pos[(size_t)t * TOPE + k];
      slot[TOPE] = p.offs[NE] + t;
    }
#pragma unroll
    for (int i = 0; i < 4; ++i) {
      const int c = lane * 4 + 256 * i;
      const f32x4 xv = *(const f32x4*)(xin + (size_t)t * D + c);
      f32x4 y;
      if (COMBINE) {
        f32x4 r = (f32x4){0, 0, 0, 0};
#pragma unroll
        for (int k = 0; k < TOPE + 1; ++k) {
          const uint2 ov = *(const uint2*)(p.osort + (size_t)slot[k] * D + c);
          r.x += __uint_as_float(ov.x << 16); r.y += __uint_as_float(ov.x & 0xffff0000u);
          r.z += __uint_as_float(ov.y << 16); r.w += __uint_as_float(ov.y & 0xffff0000u);
        }
        y = r;
      } else {
        y = *(const f32x4*)(p.tmp + (size_t)t * D + c);
      }
      const f32x4 gv = *(const f32x4*)(gatev + c);
      v[i] = xv * ALPHA + gv * y;
    }
    float s = 0.f;
#pragma unroll
    for (int i = 0; i < 4; ++i) s += (v[i].x + v[i].y) + (v[i].z + v[i].w);
    const float mean = wave_sum(s) * (1.f / D);
    float q = 0.f;
#pragma unroll
    for (int i = 0; i < 4; ++i) { v[i] = v[i] - mean; q += (v[i].x * v[i].x + v[i].y * v[i].y) + (v[i].z * v[i].z + v[i].w * v[i].w); }
    const float rs = rsqrtf(wave_sum(q) * (1.f / D) + LN_EPS);
#pragma unroll
    for (int i = 0; i < 4; ++i) {
      const int c = lane * 4 + 256 * i;
      const f32x4 gg = *(const f32x4*)(lng + c), bb = *(const f32x4*)(lnb + c);
      const f32x4 o = v[i] * rs * gg + bb;
      *(f32x4*)(xout + (size_t)t * D + c) = o;
      if (hout) {
        const f32x4 sc = *(const f32x4*)(nsc + c), sh = *(const f32x4*)(nsh + c);
        const f32x4 hv = o * (sc + 1.f) + sh;
        uint2 pk; pk.x = pack2(hv.x, hv.y); pk.y = pack2(hv.z, hv.w);
        *(uint2*)(hout + (size_t)t * D + c) = pk;
        if (hfout) *(f32x4*)(hfout + (size_t)t * D + c) = hv;
      }
    }
  }
}

__device__ __forceinline__ void ph_route(const P& p, int l, int bid, int nb, char* smem) {
  const int tid = otid(), lane = tid & 63, w = tid >> 6;
  float* sel = (float*)smem + w * 128;
  float* gs = sel + 64;
  const float* bias = p.router_bias + (size_t)l * NE;
  int* cnt = p.cnt + l * NE;
  for (int i = bid * 256 + tid; i < CAPR; i += nb * 256) p.slot_tok[i] = L;
  for (int t = bid * 4 + w; t < L; t += nb * 4) {
    const float score = sigmoidf_(p.logits[(size_t)t * NE + lane]);
    const float sv = score + bias[lane];
    sel[lane] = sv;
    const int g = lane >> 3;
    int rg = 0;
#pragma unroll
    for (int j = 0; j < 8; ++j) { const int o = g * 8 + j; const float ov = sel[o]; rg += (ov > sv || (ov == sv && o < lane)) ? 1 : 0; }
    float contrib = (rg < 2) ? sv : 0.f;
    contrib += __shfl_xor(contrib, 1); contrib += __shfl_xor(contrib, 2); contrib += __shfl_xor(contrib, 4);
    if ((lane & 7) == 0) gs[g] = contrib;
    const float mygs = contrib;
    int grank = 0;
#pragma unroll
    for (int j = 0; j < 8; ++j) { const float ov = gs[j]; grank += (ov > mygs || (ov == mygs && j < g)) ? 1 : 0; }
    const float sv2 = (grank < 4) ? sv : -1e30f;
    sel[lane] = sv2;
    int rk = 0;
    for (int j = 0; j < 64; ++j) { const float ov = sel[j]; rk += (ov > sv2 || (ov == sv2 && j < lane)) ? 1 : 0; }
    const bool chosen = rk < TOPE;
    const float ssum = wave_sum(chosen ? score : 0.f);
    if (chosen) {
      const float gt = score / ssum * 2.5f;
      const int er = atomicAdd(&cnt[lane], 1);
      p.eidx[(size_t)t * TOPE + rk] = lane;
      p.gate[(size_t)t * TOPE + rk] = gt;
      p.erank[(size_t)t * TOPE + rk] = er;
    }
  }
}

__device__ __forceinline__ void ph_moe_scatter(const P& p, int l, int bid, int nb, char* smem) {
  int* soffs = (int*)smem;
  __syncthreads();
  if (otid() == 0) {
    const int* cnt = p.cnt + l * NE;
    int off = 0, nt = 0;
    for (int e = 0; e < NE; ++e) {
      soffs[e] = off;
      const int tl = (cnt[e] + MT - 1) / MT;
      if (bid == 0) { p.offs[e] = off; for (int i = 0; i < tl; ++i) p.tile_e[nt + i] = e; }
      nt += tl; off += tl * MT;
    }
    soffs[NE] = off;
    if (bid == 0) {
      p.offs[NE] = off;
      for (int i = 0; i < L / MT; ++i) p.tile_e[nt + i] = NE;
      *p.ntm = nt + L / MT;
    }
  }
  __syncthreads();
  for (int i = bid * 256 + otid(); i < L * TOPE; i += nb * 256) {
    const int e = p.eidx[i];
    const int slot = soffs[e] + p.erank[i];
    p.slot_tok[slot] = i / TOPE;
    p.slot_gate[slot] = p.gate[i];
    p.pos[i] = slot;
  }
  const int so = soffs[NE];
  for (int i = bid * 256 + otid(); i < L; i += nb * 256) { p.slot_tok[so + i] = i; p.slot_gate[so + i] = 1.0f; }
}

#define XB_XCNT(j)  (256  + 64 * (j))
#define XB_XSUB(j)  (1280 + 64 * (j))
#define XB_XGEN(j)  (2304 + 64 * (j))
#define XB_TOP      3328
#define XB_TOPGEN   3392
#define XCD_BAR_WORDS 3456
__device__ __forceinline__ unsigned xb_ld(unsigned* q) { return __hip_atomic_load(q, __ATOMIC_RELAXED, __HIP_MEMORY_SCOPE_AGENT); }
__device__ __forceinline__ unsigned xb_add(unsigned* q, unsigned v) { return __hip_atomic_fetch_add(q, v, __ATOMIC_RELAXED, __HIP_MEMORY_SCOPE_AGENT); }
struct XB { unsigned* bar; unsigned x, nloc, nx; };
__device__ XB xb_init(unsigned* bar, char* smem) {
  XB b; b.bar = bar;
  b.x = (unsigned)__builtin_amdgcn_s_getreg((3 << 11) | 20) & 0xFu;
  volatile unsigned* sw = (volatile unsigned*)smem;
  if (otid() == 0) {
    (void)xb_add(&bar[XB_XCNT(b.x)], 1u);
    const unsigned G = gridDim.x;
    unsigned sum, cnt, mine;
    for (;;) {
      sum = 0u; cnt = 0u; mine = 0u;
#pragma unroll
      for (unsigned j = 0; j < 16; ++j) { const unsigned c = xb_ld(&bar[XB_XCNT(j)]); sum += c; cnt += (c > 0u) ? 1u : 0u; mine = (j == b.x) ? c : mine; }
      if (sum == G) break;
      __builtin_amdgcn_s_sleep(1);
    }
    sw[0] = mine; sw[1] = cnt;
  }
  __syncthreads();
  b.nloc = __builtin_amdgcn_readfirstlane(sw[0]); b.nx = __builtin_amdgcn_readfirstlane(sw[1]);
  __syncthreads();
  return b;
}
__device__ __forceinline__ void gbar(const XB& b) {
  asm volatile("s_waitcnt vmcnt(0)" ::: "memory");
  __syncthreads();
  if (otid() == 0) {
    unsigned* bar = b.bar;
    __builtin_amdgcn_s_waitcnt(0);
    const unsigned old = xb_add(&bar[XB_XSUB(b.x)], 1u);
    const unsigned gen = old / b.nloc;
    if (old + 1u == (gen + 1u) * b.nloc) {
      __builtin_amdgcn_fence(__ATOMIC_RELEASE, "agent");
      asm volatile("s_waitcnt vmcnt(0)" ::: "memory");
      const unsigned og = xb_add(&bar[XB_TOP], 1u);
      const unsigned tg = og / b.nx;
      if (og + 1u == (tg + 1u) * b.nx) xb_add(&bar[XB_TOPGEN], 1u);
      else { while (xb_ld(&bar[XB_TOPGEN]) == tg) __builtin_amdgcn_s_sleep(1); }
      __builtin_amdgcn_fence(__ATOMIC_ACQUIRE, "agent");
      xb_add(&bar[XB_XGEN(b.x)], 1u);
      asm volatile("s_waitcnt vmcnt(0)" ::: "memory");
    } else {
      while (xb_ld(&bar[XB_XGEN(b.x)]) == gen) __builtin_amdgcn_s_sleep(1);
      __builtin_amdgcn_fence(__ATOMIC_ACQUIRE, "agent");
      asm volatile("s_waitcnt vmcnt(0)" ::: "memory");
    }
  }
  __syncthreads();
}

constexpr int SMEM_BYTES = 81920;
constexpr int NSCAN = 6;
#ifndef RPS
#define RPS 0
#endif
#ifndef REPS
#define REPS 0,0,0,0,0,0,0,0,0,0
#endif
constexpr int RP[10] = {REPS};

__global__ void __launch_bounds__(256, 2) mega(P p, unsigned* bar) {
  __shared__ __attribute__((aligned(16))) char smem[SMEM_BYTES];
  cg::grid_group grid = cg::this_grid();
  const int bid = blockIdx.x, nb = gridDim.x;
  ph_mod(p, bid, nb, smem);
  grid.sync();
  const XB xb = xb_init(bar, smem);
  ph_hmod(p, p.x, p.mod + 0, p.mod + D, p.h, bid, nb);
  ph_convert(p, 0, bid, nb, smem);
  gbar(xb);
  for (int l = 0; l < DEPTH; ++l) {
    const float* mod = p.mod + (size_t)l * 6 * D;
    for (int r = 0; r < 8 * RP[9]; ++r) gbar(xb);
    {
      BG g{}; g.A = p.h; g.lda = D; g.Bt = p.wb_in; g.K = D; g.C = p.proj; g.ldc = PINP; g.ntm = L / 128; g.ntn = PINP / 128;
      for (int r = 0; r <= RP[0]; ++r) ph_bgemm<0>(g, bid, nb, smem);
    }
    gbar(xb);
    for (int r = 0; r <= RP[1]; ++r) ph_pre1(p, l, bid, nb);
    gbar(xb);
    for (int r = 0; r <= RP[1]; ++r) {
      BG g{}; g.lda = 256; g.ldc = 3 * RW; g.ntm = L / 128; g.ntn = 3;
      g.A = p.loraA; g.Bt = p.wb_w2; g.K = 64; g.C = p.lacc; ph_bgemm<1>(g, bid, nb, smem);
      g.A = p.loraA + 64; g.Bt = p.wb_a2; g.K = 64; g.C = p.lacc + RW; ph_bgemm<1>(g, bid, nb, smem);
      g.A = p.loraA + 128; g.Bt = p.wb_g2; g.K = 128; g.C = p.lacc + 2 * RW; ph_bgemm<1>(g, bid, nb, smem);
      g.lda = PINP; g.ldc = 512; g.ntn = 1; g.K = 64;
      for (int hd = 0; hd < 4; ++hd) { g.A = p.proj + C_DQ + hd * 64; g.Bt = p.wb_uk + (size_t)hd * KVL * 64; g.C = p.qlat + hd * KVL; ph_bgemm<1>(g, bid, nb, smem); }
    }
    gbar(xb);
    for (int r = 0; r <= RP[1]; ++r) ph_pre3(p, l, bid, nb);
    gbar(xb);
    for (int r = 0; r <= RP[7]; ++r) ph_rwkv_chunk(p, bid, nb, smem);
    gbar(xb);
    if (bid < NSCAN) { for (int r = 0; r <= RPS; ++r) ph_rwkv_chain(p, bid, smem); }
    else { for (int r = 0; r <= RP[6]; ++r) { ph_idx_scores(p, bid - NSCAN, nb - NSCAN, smem); ph_swa(p, l, bid - NSCAN, nb - NSCAN, smem); } }
    gbar(xb);
    for (int r = 0; r <= RP[2]; ++r) { ph_topk(p, bid, nb, smem); ph_rwkv_post(p, l, bid, nb); }
    gbar(xb);
    for (int r = 0; r <= RP[3]; ++r) ph_dsa_attn(p, l, bid, nb, smem);
    gbar(xb);
    {
      BG g{}; g.A = p.mixed; g.lda = MXW; g.Bt = p.wb_out; g.K = MXW; g.C = p.tmp; g.ldc = D; g.ntm = L / 128; g.ntn = D / 128;
      for (int r = 0; r <= RP[0]; ++r) ph_bgemm<1>(g, bid, nb, smem);
    }
    gbar(xb);
    {
      const float* xin = (l == 0) ? p.x : p.xb;
      for (int r = 0; r <= RP[8]; ++r) ph_ln<false>(p, xin, mod + 2 * D, p.ln_mix_g + (size_t)l * D, p.ln_mix_b + (size_t)l * D, p.xa, mod + 3 * D, mod + 4 * D, p.h, p.hf, bid, nb, smem);
    }
    gbar(xb);
    for (int r = 0; r <= RP[8]; ++r) ph_router_gemm(p, l, bid, nb, smem);
    gbar(xb);
    ph_route(p, l, bid, nb, smem);
    gbar(xb);
    for (int r = 0; r <= RP[8]; ++r) ph_moe_scatter(p, l, bid, nb, smem);
    gbar(xb);
    {
      BG g{}; g.A = p.h; g.lda = D; g.rowidx = p.slot_tok; g.Bt = p.wb_up; g.bstride = (long)512 * D; g.tile_e = p.tile_e; g.K = D;
      g.C = p.hid; g.ldc = DE; g.ntm_ptr = p.ntm; g.ntn = 4;
      for (int r = 0; r <= RP[4]; ++r) ph_bgemm<2>(g, bid, nb, smem);
    }
    gbar(xb);
    {
      BG g{}; g.A = p.hid; g.lda = DE; g.Bt = p.wb_dn; g.bstride = (long)D * DE; g.tile_e = p.tile_e; g.K = DE;
      g.C = p.osort; g.ldc = D; g.rowscale = p.slot_gate; g.ntm_ptr = p.ntm; g.ntn = D / 128;
      for (int r = 0; r <= RP[4]; ++r) ph_bgemm<3>(g, bid, nb, smem);
    }
    gbar(xb);
    {
      const bool last = (l == DEPTH - 1);
      const float* nmod = mod + 6 * D;
      for (int r = 0; r <= RP[5]; ++r) {
      ph_ln<true>(p, p.xa, mod + 5 * D, p.ln_ffn_g + (size_t)l * D, p.ln_ffn_b + (size_t)l * D, last ? p.out : p.xb,
                  nmod + 0, nmod + D, last ? nullptr : p.h, nullptr, bid, nb, smem);
      if (!last) ph_convert(p, l + 1, bid, nb, smem);
      }
    }
    if (l + 1 < DEPTH) gbar(xb);
  }
}

static inline char* carve(char*& cur, size_t bytes) { char* r = cur; cur += (bytes + 255) & ~(size_t)255; return r; }

extern "C" void kernel_launch(void* const* d_in, const int* in_sizes, int n_in,
                              void* d_out, int out_size, void* d_ws, size_t ws_size,
                              hipStream_t stream) {
  P p{};
  const float** ins = (const float**)&p.x;
  for (int i = 0; i < 35; ++i) ins[i] = (const float*)d_in[i];
  p.out = (float*)d_out;
  char* cur = (char*)d_ws;
  p.cnt = (int*)carve(cur, DEPTH * NE * 4);
  p.offs = (int*)carve(cur, (NE + 1) * 4);
  p.ntm = (int*)carve(cur, 4);
  p.tile_e = (int*)carve(cur, MAXTILES * 4);
  p.mod = (float*)carve(cur, (size_t)(DEPTH + 1) * 6 * D * 4);
  p.wb_in = (bf16_t*)carve(cur, (size_t)PINP * D * 2);
  p.wb_out = (bf16_t*)carve(cur, (size_t)D * MXW * 2);
  p.wb_w2 = (bf16_t*)carve(cur, (size_t)RW * 64 * 2);
  p.wb_a2 = (bf16_t*)carve(cur, (size_t)RW * 64 * 2);
  p.wb_g2 = (bf16_t*)carve(cur, (size_t)RW * 128 * 2);
  p.wb_uk = (bf16_t*)carve(cur, (size_t)4 * KVL * 64 * 2);
  p.wb_up = (bf16_t*)carve(cur, (size_t)NEX * 512 * D * 2);
  p.wb_dn = (bf16_t*)carve(cur, (size_t)NEX * D * DE * 2);
  p.h = (bf16_t*)carve(cur, (size_t)(L + 1) * D * 2);
  p.hf = (float*)carve(cur, (size_t)L * D * 4);
  p.mixed = (bf16_t*)carve(cur, (size_t)L * MXW * 2);
  p.xa = (float*)carve(cur, (size_t)L * D * 4);
  p.xb = (float*)carve(cur, (size_t)L * D * 4);
  p.logits = (float*)carve(cur, (size_t)L * NE * 4);
  p.gate = (float*)carve(cur, (size_t)L * TOPE * 4);
  p.eidx = (int*)carve(cur, (size_t)L * TOPE * 4);
  p.erank = (int*)carve(cur, (size_t)L * TOPE * 4);
  p.pos = (int*)carve(cur, (size_t)L * TOPE * 4);
  p.slot_tok = (int*)carve(cur, (size_t)CAP * 4);
  p.slot_gate = (float*)carve(cur, (size_t)CAP * 4);
  char* ov = cur;
  p.proj = (bf16_t*)carve(cur, (size_t)L * PINP * 2);
  p.tmp = (float*)p.proj;
  p.rw5 = (float*)carve(cur, (size_t)5 * L * RW * 4);
  p.rw_kk = p.rw5; p.rw_w = p.rw5 + (size_t)L * RW; p.rw_b = p.rw5 + (size_t)2 * L * RW; p.rw_k = p.rw5 + (size_t)3 * L * RW; p.rw_r = p.rw5 + (size_t)4 * L * RW;
  p.rw_v = (float*)carve(cur, (size_t)L * RW * 4);
  p.rw_g = (float*)carve(cur, (size_t)L * RW * 4);
  p.cMT = (bf16_t*)carve(cur, (size_t)4 * NCH * 6 * CH_ELEMS * 2);
  p.cRP = p.cMT + (size_t)NCH * 6 * CH_ELEMS; p.cNT = p.cRP + (size_t)NCH * 6 * CH_ELEMS; p.cY1 = p.cNT + (size_t)NCH * 6 * CH_ELEMS;
  p.rw_y = (float*)carve(cur, (size_t)L * RW * 4);
  p.rw_bonus = (float*)carve(cur, (size_t)L * 6 * 4);
  p.ckvb = (bf16_t*)carve(cur, (size_t)L * KVL * 2);
  p.qlat = (float*)carve(cur, (size_t)L * 512 * 4);
  p.ikn = (bf16_t*)carve(cur, (size_t)L * 64 * 2);
  p.iws = (float*)carve(cur, (size_t)L * 4 * 4);
  p.idx = (int*)carve(cur, (size_t)L * TOPK * 4);
  p.keys = (bf16_t*)carve(cur, (size_t)NQT * (NQT + 1) / 2 * 128 * 128 * 2);
  p.lacc = (float*)p.keys;
  p.loraA = (bf16_t*)((char*)p.keys + (size_t)L * 3 * RW * 4);
  char* ovend = cur;
  char* cur2 = ov;
  p.hid = (bf16_t*)carve(cur2, (size_t)CAP * DE * 2);
  p.osort = (bf16_t*)carve(cur2, (size_t)CAP * D * 2);
  if (cur2 > ovend) ovend = cur2;
  if ((size_t)(ovend - (char*)d_ws) > ws_size) { fprintf(stderr, "workspace too small: need %zu have %zu\n", (size_t)(ovend - (char*)d_ws), ws_size); return; }
  cur = ovend;

  unsigned* bar = (unsigned*)carve(cur, XCD_BAR_WORDS * 4);
  if ((size_t)(cur - (char*)d_ws) > ws_size) { fprintf(stderr, "workspace too small\n"); return; }
  hipMemsetAsync(p.cnt, 0, DEPTH * NE * 4, stream);
  hipMemsetAsync(bar, 0, XCD_BAR_WORDS * 4, stream);
  static int grid_blocks = 0;
  if (!grid_blocks) {
    int dev = 0, cus = 0, per_cu = 0;
    (void)hipGetDevice(&dev);
    (void)hipDeviceGetAttribute(&cus, hipDeviceAttributeMultiprocessorCount, dev);
    (void)hipOccupancyMaxActiveBlocksPerMultiprocessor(&per_cu, mega, 256, 0);
    if (per_cu > 2) per_cu = 2;
    if (per_cu < 1) per_cu = 1;
    grid_blocks = cus * per_cu;
  }
  void* args[] = {&p, &bar};
  hipError_t e = hipLaunchCooperativeKernel((void*)mega, dim3(grid_blocks), dim3(256), args, 0, stream);
  if (e != hipSuccess) fprintf(stderr, "cooperative launch failed: %s (grid %d)\n", hipGetErrorString(e), grid_blocks);
}
```
